# Optimizing an MI355X kernel written in HIP

```python
import math
import jax, jax.numpy as jnp
from jax import lax
import numpy as np

D_MODEL = 1024
BATCH = 2
SEQ = 8192
DEPTH = 2

N_MIXERS = 2
N_RET_LAYERS = (DEPTH + N_MIXERS - 1) // N_MIXERS
N_S5_LAYERS = DEPTH // N_MIXERS
N_MOD = 9
D_FF = 2816
RET_HEADS = 4
RET_QK_DIM = D_MODEL // RET_HEADS
RET_V_DIM = 2 * D_MODEL // RET_HEADS
RET_CHUNK = 128
ROPE_THETA = 10000.0
S5_GROUP = 16
S5_GROUPS = D_MODEL // S5_GROUP
S5_STATE = 64
DT_MIN = 0.001
DT_MAX = 0.1
NORM_EPS = 1e-6
GN_EPS = 1e-5

kernel_name = "hybrid_retention_s5_macaron_adaln"


def rms_norm(x, g):
    xf = x.astype(jnp.float32)
    y = xf * lax.rsqrt(jnp.mean(xf * xf, axis=-1, keepdims=True) + NORM_EPS)
    return (y * g.astype(jnp.float32)).astype(x.dtype)


def modulate(h, shift, scale):
    return h * (1.0 + scale[:, None, :]) + shift[:, None, :]


def swiglu_ffn(h, w_in, w_out):
    gate, up = jnp.split(h @ w_in, 2, axis=-1)
    return (jax.nn.silu(gate) * up) @ w_out


def rotary(t, positions):
    half = t.shape[-1] // 2
    inv_freq = ROPE_THETA ** (-jnp.arange(half, dtype=jnp.float32) / half)
    ang = positions.astype(jnp.float32)[..., None] * inv_freq
    cos = jnp.cos(ang)[:, :, None, :]
    sin = jnp.sin(ang)[:, :, None, :]
    t1, t2 = t[..., :half], t[..., half:]
    return jnp.concatenate([t1 * cos - t2 * sin, t1 * sin + t2 * cos], axis=-1)


def retention(h, positions, w_in, w_out):
    B, L, _ = h.shape
    H, dk, dv, C = RET_HEADS, RET_QK_DIM, RET_V_DIM, RET_CHUNK
    N = L // C
    qk_w, v_w = H * dk, H * dv
    q, k, v, g = jnp.split(h @ w_in, [qk_w, 2 * qk_w, 2 * qk_w + v_w], axis=-1)
    q = rotary(q.reshape(B, L, H, dk).astype(jnp.float32), positions)
    k = rotary(k.reshape(B, L, H, dk).astype(jnp.float32), positions) * (dk ** -0.5)
    v = v.reshape(B, L, H, dv).astype(jnp.float32)

    log_gamma = jnp.log(1.0 - jnp.power(2.0, -5.0 - jnp.arange(H, dtype=jnp.float32)))
    pos = jnp.arange(C, dtype=jnp.float32)
    diff = pos[:, None] - pos[None, :]
    decay_mask = jnp.where(diff >= 0,
                           jnp.exp(log_gamma[:, None, None] * jnp.maximum(diff, 0.0)),
                           0.0)
    q_decay = jnp.exp(log_gamma[:, None] * (pos + 1.0))[None, :, :, None]
    k_decay = jnp.exp(log_gamma[:, None] * (C - 1.0 - pos))[None, :, :, None]
    chunk_decay = jnp.exp(log_gamma * C)[None, :, None, None]

    def to_chunks(t):
        return t.reshape(B, N, C, H, -1).transpose(1, 0, 3, 2, 4)

    def step(state, qkv):
        qc, kc, vc = qkv
        scores = jnp.einsum('bhid,bhjd->bhij', qc, kc) * decay_mask
        inner = jnp.einsum('bhij,bhje->bhie', scores, vc)
        cross = jnp.einsum('bhid,bhde->bhie', qc, state) * q_decay
        state = state * chunk_decay + jnp.einsum('bhjd,bhje->bhde', kc * k_decay, vc)
        return state, inner + cross

    state0 = jnp.zeros((B, H, dk, dv), jnp.float32)
    _, o = lax.scan(step, state0, (to_chunks(q), to_chunks(k), to_chunks(v)))
    o = o.transpose(1, 0, 3, 2, 4).reshape(B, L, H, dv)
    mu = jnp.mean(o, axis=-1, keepdims=True)
    var = jnp.mean(jnp.square(o - mu), axis=-1, keepdims=True)
    o = ((o - mu) * lax.rsqrt(var + GN_EPS)).reshape(B, L, v_w).astype(h.dtype)
    return (jax.nn.silu(g) * o) @ w_out


def s5_layer(u, a_re, a_im, b_re, b_im, c_re, c_im, d_skip, log_dt, w_glu):
    Bsz, L, Dm = u.shape
    G, P, K = S5_GROUPS, S5_STATE, S5_GROUP
    f32 = jnp.float32
    A = lax.complex(a_re.astype(f32), a_im.astype(f32))
    dt = jnp.exp(log_dt.astype(f32))[:, None]
    A_bar = jnp.exp(dt * A)
    B_mat = lax.complex(b_re.astype(f32), b_im.astype(f32))
    B_bar = ((A_bar - 1.0) / A)[..., None] * B_mat
    C_mat = lax.complex(c_re.astype(f32), c_im.astype(f32))

    uf = u.astype(f32)
    ug = uf.reshape(Bsz, L, G, K).astype(jnp.complex64)
    bu = jnp.einsum('blgk,gpk->blgp', ug, B_bar)
    a = jnp.broadcast_to(A_bar, (1, L, G, P))

    def combine(left, right):
        a_l, b_l = left
        a_r, b_r = right
        return a_l * a_r, a_r * b_l + b_r

    _, states = lax.associative_scan(combine, (a, bu), axis=1)
    y = jnp.einsum('gkp,blgp->blgk', C_mat, states).real.reshape(Bsz, L, Dm)
    y = jax.nn.gelu(y + d_skip.astype(f32) * uf).astype(u.dtype)
    y1, y2 = jnp.split(y @ w_glu, 2, axis=-1)
    return y1 * jax.nn.sigmoid(y2)


def setup_inputs(seed: int = 0) -> dict:
    key = jax.random.key(seed)
    ks = jax.random.split(key, 20)
    D, f32 = D_MODEL, jnp.float32
    G, P, K = S5_GROUPS, S5_STATE, S5_GROUP
    nrm = lambda k, shape, s: jax.random.normal(k, shape, f32) * s
    x = nrm(ks[0], (BATCH, SEQ, D), 1.0)
    c = nrm(ks[1], (BATCH, D), 1.0)
    positions = jnp.broadcast_to(jnp.arange(SEQ, dtype=jnp.int32), (BATCH, SEQ))
    ada_w = nrm(ks[2], (DEPTH, D, N_MOD * D), 0.5 * D ** -0.5)
    ada_b = nrm(ks[3], (DEPTH, N_MOD * D), 0.01)
    norm_g = 1.0 + nrm(ks[4], (DEPTH, 3, D), 0.02)
    ffn_w_in = nrm(ks[5], (DEPTH, 2, D, 2 * D_FF), D ** -0.5)
    ffn_w_out = nrm(ks[6], (DEPTH, 2, D_FF, D), D_FF ** -0.5)
    ret_in_w = 2 * RET_HEADS * RET_QK_DIM + 2 * RET_HEADS * RET_V_DIM
    ret_w_in = nrm(ks[7], (N_RET_LAYERS, D, ret_in_w), D ** -0.5)
    ret_w_out = nrm(ks[8], (N_RET_LAYERS, RET_HEADS * RET_V_DIM, D), (RET_HEADS * RET_V_DIM) ** -0.5)
    s5_a_re = -0.5 + nrm(ks[9], (N_S5_LAYERS, G, P), 0.01)
    s5_a_im = jnp.broadcast_to(math.pi * jnp.arange(P, dtype=f32), (N_S5_LAYERS, G, P))
    s5_b_re = nrm(ks[10], (N_S5_LAYERS, G, P, K), (2 * K) ** -0.5)
    s5_b_im = nrm(ks[11], (N_S5_LAYERS, G, P, K), (2 * K) ** -0.5)
    s5_c_re = nrm(ks[12], (N_S5_LAYERS, G, K, P), (2 * P) ** -0.5)
    s5_c_im = nrm(ks[13], (N_S5_LAYERS, G, K, P), (2 * P) ** -0.5)
    s5_d = nrm(ks[14], (N_S5_LAYERS, D), 1.0)
    s5_log_dt = jax.random.uniform(ks[15], (N_S5_LAYERS, G), f32,
                                   math.log(DT_MIN), math.log(DT_MAX))
    s5_w_glu = nrm(ks[16], (N_S5_LAYERS, D, 2 * D), D ** -0.5)
    final_g = 1.0 + nrm(ks[17], (D,), 0.02)
    return {"x": x, "c": c, "positions": positions,
            "ada_w": ada_w, "ada_b": ada_b, "norm_g": norm_g,
            "ffn_w_in": ffn_w_in, "ffn_w_out": ffn_w_out,
            "ret_w_in": ret_w_in, "ret_w_out": ret_w_out,
            "s5_a_re": s5_a_re, "s5_a_im": s5_a_im,
            "s5_b_re": s5_b_re, "s5_b_im": s5_b_im,
            "s5_c_re": s5_c_re, "s5_c_im": s5_c_im,
            "s5_d": s5_d, "s5_log_dt": s5_log_dt, "s5_w_glu": s5_w_glu,
            "final_g": final_g}


def reference(x, c, positions, ada_w, ada_b, norm_g, ffn_w_in, ffn_w_out,
              ret_w_in, ret_w_out, s5_a_re, s5_a_im, s5_b_re, s5_b_im,
              s5_c_re, s5_c_im, s5_d, s5_log_dt, s5_w_glu, final_g):
    c_act = jax.nn.silu(c)
    for i in range(DEPTH):
        mods = jnp.split(c_act @ ada_w[i] + ada_b[i], N_MOD, axis=-1)
        sh1, sc1, g1, sh2, sc2, g2, sh3, sc3, g3 = mods
        h = modulate(rms_norm(x, norm_g[i, 0]), sh1, sc1)
        x = x + 0.5 * g1[:, None, :] * swiglu_ffn(h, ffn_w_in[i, 0], ffn_w_out[i, 0])
        h = modulate(rms_norm(x, norm_g[i, 1]), sh2, sc2)
        j = i // N_MIXERS
        if i % N_MIXERS == 0:
            m = retention(h, positions, ret_w_in[j], ret_w_out[j])
        else:
            m = s5_layer(h, s5_a_re[j], s5_a_im[j], s5_b_re[j], s5_b_im[j],
                         s5_c_re[j], s5_c_im[j], s5_d[j], s5_log_dt[j], s5_w_glu[j])
        x = x + g2[:, None, :] * m
        h = modulate(rms_norm(x, norm_g[i, 2]), sh3, sc3)
        x = x + 0.5 * g3[:, None, :] * swiglu_ffn(h, ffn_w_in[i, 1], ffn_w_out[i, 1])
    return rms_norm(x, final_g)
```

```cpp
#include <hip/hip_runtime.h>
#include <hip/hip_cooperative_groups.h>
#include <cstdio>
#include <cstdint>
namespace cg = cooperative_groups;
namespace pg8 {
#define PG8_LAS __attribute__((address_space(3)))
typedef unsigned short bf16_t;
typedef short bf16x8 __attribute__((ext_vector_type(8)));
typedef float f32x4 __attribute__((ext_vector_type(4)));
typedef unsigned u32x4 __attribute__((ext_vector_type(4)));
constexpr int BM = 256, BK = 64, HALF = 128, HTB = HALF * BK * 2  , STAGE_BYTES = 8 * HTB, NXCD = 8, WGM = 8;

__host__ __device__ __forceinline__ int lds_byte(int r, int c) { const int st = (r >> 4) * 2 + (c >> 5), rr = r & 15, cc = c & 31, ob = rr * 64 + cc * 2; return st * 1024 + (ob ^ (((ob >> 9) & 1) << 5)); }
__host__ __device__ __forceinline__ void stage_rc(int b, int& R, int& C) { const int st = b / 1024, sb = b % 1024, swz = sb ^ (((sb >> 9) & 1) << 5); R = (st >> 1) * 16 + swz / 64; C = (st & 1) * 32 + (swz % 64) / 2; }
__host__ __device__ __forceinline__ int perm32(int rho) { const int n = rho >> 4, i = rho & 15; return 8 * (i >> 2) + 4 * n + (i & 3); }

struct Unit { int pm, pn; };
struct Gemm { const bf16_t* A; const bf16_t* Bt; int M, N, K; };

struct StaticOrder {
    int nM, nN, nwg, G, c;
    __host__ __device__ void init(int M, int N, int G_, int c_) { nM = M / BM; nN = N / BM; nwg = nM * nN; G = G_; c = c_; }
    __host__ __device__ bool next(int i, Unit& u) const {
        const long L = (long)i * G + c; if (L >= nwg) return false;
        int wgid = (int)L; { const int q = nwg / NXCD, r = nwg % NXCD, xcd = wgid % NXCD, off = wgid / NXCD; wgid = (xcd < r ? xcd * (q + 1) : r * (q + 1) + (xcd - r) * q) + off; }
        const int nig = WGM * nN, gid = wgid / nig, fm = gid * WGM, gsz = (nM - fm) < WGM ? (nM - fm) : WGM;
        u.pm = fm + ((wgid % nig) % gsz); u.pn = (wgid % nig) / gsz; return true;
    }
    __device__ __forceinline__ void a_ready(const Unit&) const {}
    __device__ __forceinline__ void done(const Unit&) const {}
};
__device__ __forceinline__ unsigned cvt_pk_bf16(float lo, float hi) { unsigned r; asm volatile("v_cvt_pk_bf16_f32 %0, %1, %2" : "=v"(r) : "v"(lo), "v"(hi)); return r; }
typedef float f32x2 __attribute__((ext_vector_type(2)));
typedef unsigned u32x2 __attribute__((ext_vector_type(2)));
typedef _Float16 h16x4 __attribute__((ext_vector_type(4)));
__device__ __forceinline__ float silu_f(float v) { return v * __builtin_amdgcn_rcpf(1.f + __expf(-v)); }
__device__ __forceinline__ float sigm_f(float v) { return __builtin_amdgcn_rcpf(1.f + __expf(-v)); }
__device__ __forceinline__ u32x4 pack8(f32x4 a, f32x4 b) { u32x4 w; w.x = cvt_pk_bf16(a[0], a[1]); w.y = cvt_pk_bf16(a[2], a[3]); w.z = cvt_pk_bf16(b[0], b[1]); w.w = cvt_pk_bf16(b[2], b[3]); return w; }

struct EpiSwiGLU {
    static constexpr bool PERM = true, AFTER_DRAIN = false;
    bf16_t* O; int ldc;
    __device__ __forceinline__ void operator()(const f32x4 (&acc)[2][2][4][2], const Unit& u, int wr, int wc, int fr, int fq) const {
        asm volatile("" : "+v"(fr), "+v"(fq));
        const int row0 = u.pm * BM + wr * 64 + fr, col0 = u.pn * HALF + wc * 32 + 8 * fq;
#pragma unroll
        for (int ai = 0; ai < 2; ++ai)
#pragma unroll
            for (int m = 0; m < 4; ++m) {
                bf16_t* rowp = O + (size_t)(row0 + ai * HALF + m * 16) * ldc + col0;
                f32x4 o0, o1;
#pragma unroll
                for (int i = 0; i < 4; ++i) { o0[i] = silu_f(acc[ai][0][m][0][i]) * acc[ai][1][m][0][i]; o1[i] = silu_f(acc[ai][0][m][1][i]) * acc[ai][1][m][1][i]; }
                *(u32x4*)rowp = pack8(o0, o1);
            }
    }
};
struct EpiResid {
    static constexpr bool PERM = false, AFTER_DRAIN = true;
    const bf16_t* base; bf16_t* out; const float* gate; float gs;
    __device__ __forceinline__ void fused(f32x4 (&acc)[2][2][4][2], const Unit& u, int wr, int wc, int fr, int fq, PG8_LAS unsigned char* lds, int wid, int lane) const {
        asm volatile("" : "+v"(fr), "+v"(fq), "+v"(lane));
        PG8_LAS float* T = (PG8_LAS float*)lds;
        const int b = u.pm >> 5;
        const f32x4 gv = *(const f32x4*)(gate + b * 9216 + u.pn * BM + 4 * lane) * gs;
        h16x4 bsr[4][8];
#pragma unroll
        for (int ps = 0; ps < 4; ++ps)
#pragma unroll
            for (int q = 0; q < 8; ++q) {
                const int rl = wid * 8 + q, actual = (ps >> 1) * HALF + 64 * (rl >> 5) + 16 * (2 * (ps & 1) + ((rl >> 4) & 1)) + (rl & 15);
                bsr[ps][q] = *(const h16x4*)(base + (size_t)(u.pm * BM + actual) * 1024 + u.pn * BM + 4 * lane);
            }
#pragma unroll
        for (int ai = 0; ai < 2; ++ai)
#pragma unroll
            for (int mh = 0; mh < 2; ++mh) {
#pragma unroll
                for (int mp = 0; mp < 2; ++mp)
#pragma unroll
                    for (int bj = 0; bj < 2; ++bj)
#pragma unroll
                        for (int n = 0; n < 2; ++n)
                            *(PG8_LAS f32x4*)(T + (wr * 32 + mp * 16 + fr) * 272 + bj * HALF + wc * 32 + n * 16 + 4 * fq) = acc[ai][bj][2 * mh + mp][n];
                __syncthreads();
#pragma unroll
                for (int q = 0; q < 8; ++q) {
                    const int rl = wid * 8 + q, actual = ai * HALF + 64 * (rl >> 5) + 16 * (2 * mh + ((rl >> 4) & 1)) + (rl & 15);
                    const size_t off = (size_t)(u.pm * BM + actual) * 1024 + u.pn * BM + 4 * lane;
                    const f32x4 bs = __builtin_convertvector(bsr[2 * ai + mh][q], f32x4);
                    const f32x4 o = bs + gv * *(const PG8_LAS f32x4*)(T + rl * 272 + 4 * lane);
                    *(h16x4*)(out + off) = __builtin_convertvector(o, h16x4);
                }
                __syncthreads();
            }
    }
};
struct EpiGLU {
    static constexpr bool PERM = true, AFTER_DRAIN = false;
    bf16_t* xr; const float* gate;
    __device__ __forceinline__ void operator()(const f32x4 (&acc)[2][2][4][2], const Unit& u, int wr, int wc, int fr, int fq) const {
        asm volatile("" : "+v"(fr), "+v"(fq));
        const int b = u.pm >> 5, col = u.pn * HALF + wc * 32 + 8 * fq;
        const f32x4 g0 = *(const f32x4*)(gate + b * 9216 + col), g1 = *(const f32x4*)(gate + b * 9216 + col + 4);
        h16x4 rr[2][4][2];
#pragma unroll
        for (int ai = 0; ai < 2; ++ai)
#pragma unroll
            for (int m = 0; m < 4; ++m) {
                const size_t off = (size_t)(u.pm * BM + ai * HALF + wr * 64 + m * 16 + fr) * 1024 + col;
                rr[ai][m][0] = *(const h16x4*)(xr + off); rr[ai][m][1] = *(const h16x4*)(xr + off + 4);
            }
#pragma unroll
        for (int ai = 0; ai < 2; ++ai)
#pragma unroll
            for (int m = 0; m < 4; ++m) {
                const size_t off = (size_t)(u.pm * BM + ai * HALF + wr * 64 + m * 16 + fr) * 1024 + col;
                const f32x4 r0 = __builtin_convertvector(rr[ai][m][0], f32x4), r1 = __builtin_convertvector(rr[ai][m][1], f32x4);
                f32x4 o0, o1;
#pragma unroll
                for (int t = 0; t < 4; ++t) {
                    o0[t] = r0[t] + g0[t] * (acc[ai][0][m][0][t] * sigm_f(acc[ai][1][m][0][t]));
                    o1[t] = r1[t] + g1[t] * (acc[ai][0][m][1][t] * sigm_f(acc[ai][1][m][1][t]));
                }
                *(h16x4*)(xr + off) = __builtin_convertvector(o0, h16x4); *(h16x4*)(xr + off + 4) = __builtin_convertvector(o1, h16x4);
            }
    }
};
struct EpiRet3a {
    static constexpr bool PERM = true, AFTER_DRAIN = false;
    bf16_t* G; bf16_t* Q; bf16_t* K; bf16_t* KD; const float* rot;
    __device__ __forceinline__ void operator()(const f32x4 (&acc)[2][2][4][2], const Unit& u, int wr, int wc, int fr, int fq) const {
        asm volatile("" : "+v"(fr), "+v"(fq));
        const int row0 = u.pm * BM + wr * 64 + fr;
        if (u.pn < 8) {
            const int col0 = u.pn * BM + wc * 32 + 8 * fq;
#pragma unroll
            for (int ai = 0; ai < 2; ++ai)
#pragma unroll
                for (int m = 0; m < 4; ++m)
#pragma unroll
                    for (int bj = 0; bj < 2; ++bj) {
                        f32x4 o0, o1;
#pragma unroll
                        for (int i = 0; i < 4; ++i) { o0[i] = silu_f(acc[ai][bj][m][0][i]); o1[i] = silu_f(acc[ai][bj][m][1][i]); }
                        *(u32x4*)(G + (size_t)(row0 + ai * HALF + m * 16) * 2048 + col0 + bj * HALF) = pack8(o0, o1);
                    }
        } else {
            const int h = (u.pn - 8) & 3; const bool isk = u.pn >= 12; bf16_t* dst = isk ? K : Q; const float sc = isk ? 0.0625f : 1.0f;
            const int d0 = wc * 32 + 8 * fq;
#pragma unroll
            for (int ai = 0; ai < 2; ++ai)
#pragma unroll
                for (int m = 0; m < 4; ++m) {
                    const int row = row0 + ai * HALF + m * 16;
                    const f32x4* rp = (const f32x4*)(rot + ((size_t)row * 128 + d0) * 2);
                    f32x4 o1[2], o2[2];
#pragma unroll
                    for (int n = 0; n < 2; ++n) {
                        const f32x4 r0 = rp[2 * n], r1 = rp[2 * n + 1];
                        const f32x4 c = {r0[0], r0[2], r1[0], r1[2]}, s = {r0[1], r0[3], r1[1], r1[3]};
                        const f32x4 t1 = acc[ai][0][m][n], t2 = acc[ai][1][m][n];
                        o1[n] = (t1 * c - t2 * s) * sc; o2[n] = (t1 * s + t2 * c) * sc;
                    }
                    const size_t po = ((size_t)(row >> 4) * 32 + 8 * h + wc) * 512 + (fq * 16 + (row & 15)) * 8;
                    const float dec = isk ? __builtin_amdgcn_exp2f(log2f(1.0f - exp2f(-5.0f - (float)h)) * (float)(127 - (row & 127))) : 1.0f;
                    bf16_t* p = (isk ? KD : Q) + po;
                    *(u32x4*)p = pack8(o1[0] * dec, o1[1] * dec); *(u32x4*)(p + 4 * 512) = pack8(o2[0] * dec, o2[1] * dec);
                    asm volatile("" ::: "memory");
                }
        }
    }
};
struct EpiRet3b {
    static constexpr bool PERM = true, AFTER_DRAIN = false;
    bf16_t* VT;
    __device__ __forceinline__ void operator()(const f32x4 (&acc)[2][2][4][2], const Unit& u, int wr, int wc, int fr, int fq) const {
        asm volatile("" : "+v"(fr), "+v"(fq));
        const int f0 = u.pm * BM + wr * 64 + fr, t0 = u.pn * BM + wc * 32 + 8 * fq;
#pragma unroll
        for (int ai = 0; ai < 2; ++ai)
#pragma unroll
            for (int m = 0; m < 4; ++m)
#pragma unroll
                for (int bj = 0; bj < 2; ++bj)
                    *(u32x4*)(VT + ((size_t)((f0 + ai * HALF + m * 16) >> 4) * 256 + ((t0 + bj * HALF) >> 5)) * 512 + (fq * 16 + fr) * 8) = pack8(acc[ai][bj][m][0], acc[ai][bj][m][1]);
    }
};
struct S5Order {
    int G, c;
    __host__ __device__ bool next(int i, Unit& u) const { const int L = i * G + c; if (L >= 256) return false; u.pm = L; u.pn = L >> 2; return true; }
    __device__ __forceinline__ void a_ready(const Unit&) const {}
    __device__ __forceinline__ void done(const Unit&) const {}
};
struct EpiS5A {
    static constexpr bool PERM = true, AFTER_DRAIN = false;
    float* Sloc;
    __device__ __forceinline__ void operator()(const f32x4 (&acc)[2][2][4][2], const Unit& u, int wr, int wc, int fr, int fq) const {
        asm volatile("" : "+v"(fr), "+v"(fq));
        const int g = u.pn, c0 = (u.pm & 3) * BM + wr * 64 + fr, n0 = wc * 32 + 8 * fq;
#pragma unroll
        for (int ai = 0; ai < 2; ++ai)
#pragma unroll
            for (int m = 0; m < 4; ++m) {
                float* p = Sloc + ((size_t)(c0 + ai * HALF + m * 16) * 64 + g) * 128 + n0;
                *(f32x4*)p = acc[ai][0][m][0]; *(f32x4*)(p + 4) = acc[ai][0][m][1];
            }
    }
};
struct EpiS5C {
    static constexpr bool PERM = true, AFTER_DRAIN = false;
    const bf16_t* XN; const float* dsk; bf16_t* YG;
    __device__ __forceinline__ void operator()(const f32x4 (&acc)[2][2][4][2], const Unit& u, int wr, int wc, int fr, int fq) const {
        asm volatile("" : "+v"(fr), "+v"(fq));
        const int g = u.pn, c0 = (u.pm & 3) * BM + wr * 64 + fr, ch = 16 * g + 8 * (fq & 1);
        const f32x4 d0 = *(const f32x4*)(dsk + ch), d1 = *(const f32x4*)(dsk + ch + 4);
#pragma unroll
        for (int ai = 0; ai < 2; ++ai)
#pragma unroll
            for (int m = 0; m < 4; ++m)
#pragma unroll
                for (int bj = 0; bj < 2; ++bj) {
                    const int i = 8 * bj + 2 * wc + (fq >> 1);
                    const size_t idx = (size_t)(16 * (c0 + ai * HALF + m * 16) + i) * 1024 + ch;
                    const u32x4 uv = *(const u32x4*)(XN + idx);
                    f32x4 y0 = acc[ai][bj][m][0], y1 = acc[ai][bj][m][1];
#pragma unroll
                    for (int t = 0; t < 2; ++t) {
                        y0[2 * t] += d0[2 * t] * __builtin_bit_cast(float, uv[t] << 16); y0[2 * t + 1] += d0[2 * t + 1] * __builtin_bit_cast(float, uv[t] & 0xffff0000u);
                        y1[2 * t] += d1[2 * t] * __builtin_bit_cast(float, uv[2 + t] << 16); y1[2 * t + 1] += d1[2 * t + 1] * __builtin_bit_cast(float, uv[2 + t] & 0xffff0000u);
                    }
#pragma unroll
                    for (int t = 0; t < 4; ++t) {
                        const float a = y0[t], b = y1[t];
                        y0[t] = a * __builtin_amdgcn_rcpf(1.f + __expf(-1.5957691216f * (a + 0.044715f * a * a * a)));
                        y1[t] = b * __builtin_amdgcn_rcpf(1.f + __expf(-1.5957691216f * (b + 0.044715f * b * b * b)));
                    }
                    *(u32x4*)(YG + idx) = pack8(y0, y1);
                }
    }
};
template <class Epi, class Sched, bool ALIGN_EPI = false, bool SP2 = false>
__device__ __forceinline__ void gemm_phase(PG8_LAS unsigned char* lds, const Gemm g, const Sched& S, const Epi& E) {
    int tid_ = threadIdx.x; asm volatile("" : "+v"(tid_));
    const int tid = tid_, wid = __builtin_amdgcn_readfirstlane(tid >> 6), lane = tid & 63, wr = wid >> 2, wc = wid & 3, fr = lane & 15, fq = lane >> 4;
    const int K = g.K, nt = K / BK;
    unsigned voffA[2], voffB[2];
#pragma unroll
    for (int i = 0; i < 2; ++i) { int R, C; stage_rc(tid * 16 + i * 8192, R, C); const int Rb = Epi::PERM ? ((R & ~31) + perm32(R & 31)) : R;
        voffA[i] = (unsigned)(R * K + C) * 2u; voffB[i] = (unsigned)(Rb * K + C) * 2u; }
    const size_t kstep = (size_t)(BK * 2);
    const size_t hstep = (size_t)HALF * K * 2;
    const size_t tstep = 2 * hstep;
    const unsigned ldsw = (unsigned)wid * 1024u;
    const int aoff = lds_byte(wr * 64 + fr, fq * 8), boff = lds_byte(wc * 32 + fr, fq * 8);
#define PG8_SA(b, h) (((b) * 2 + (h)) * HTB)
#define PG8_SB(b, h) ((4 + (b) * 2 + (h)) * HTB)
#define PG8_STAGE(bufoff, gbase, voff) do { _Pragma("unroll") for (int _i = 0; _i < 2; ++_i) \
        __builtin_amdgcn_global_load_lds((const unsigned*)((const char*)(gbase) + (voff)[_i]), (PG8_LAS unsigned*)(lds + (bufoff) + ldsw + _i * 8192), 16, 0, 0); } while (0)
#define PG8_LDA(dst, b, h) do { _Pragma("unroll") for (int m = 0; m < 4; ++m) _Pragma("unroll") for (int k = 0; k < 2; ++k) dst[m][k] = *(const PG8_LAS bf16x8*)(lds + PG8_SA(b, h) + aoff + m * 2048 + k * 1024); } while (0)
#define PG8_LDB(dst, b, h) do { _Pragma("unroll") for (int n = 0; n < 2; ++n) _Pragma("unroll") for (int k = 0; k < 2; ++k) dst[n][k] = *(const PG8_LAS bf16x8*)(lds + PG8_SB(b, h) + boff + n * 2048 + k * 1024); } while (0)
#define PG8_MMA(ai, bj, At, Bt) do { __builtin_amdgcn_s_setprio(1); _Pragma("unroll") for (int m = 0; m < 4; ++m) _Pragma("unroll") for (int n = 0; n < 2; ++n) _Pragma("unroll") for (int k = 0; k < 2; ++k) \
        acc[ai][bj][m][n] = __builtin_amdgcn_mfma_f32_16x16x32_bf16(Bt[n][k], At[m][k], acc[ai][bj][m][n], 0, 0, 0); __builtin_amdgcn_s_setprio(0); } while (0)
#define PG8_WAIT_V(n) asm volatile("s_waitcnt vmcnt(" #n ")" ::: "memory")
#define PG8_WAIT_L(n) asm volatile("s_waitcnt lgkmcnt(" #n ")" ::: "memory")
#define PG8_BAR __builtin_amdgcn_s_barrier()
#define PG8_SCHED __builtin_amdgcn_sched_barrier(0)
    Unit cur, nxt; int ui = 0;
    if (!S.next(0, cur)) return;
    f32x4 acc[2][2][4][2];
#pragma unroll
    for (int a = 0; a < 2; ++a)
#pragma unroll
        for (int b = 0; b < 2; ++b)
#pragma unroll
            for (int m = 0; m < 4; ++m)
#pragma unroll
                for (int n = 0; n < 2; ++n) acc[a][b][m][n] = (f32x4){0.f, 0.f, 0.f, 0.f};
    bf16x8 At[4][2], B0[2][2], B1[2][2];
    const char* cA = (const char*)g.A + (size_t)cur.pm * tstep; const char* cB = (const char*)g.Bt + (size_t)cur.pn * tstep;
    S.a_ready(cur);
    if constexpr (SP2) {
        PG8_STAGE(PG8_SB(0, 0), cB, voffB); PG8_STAGE(PG8_SB(0, 1), cB + hstep, voffB); PG8_STAGE(PG8_SA(0, 0), cA, voffA); PG8_STAGE(PG8_SA(0, 1), cA + hstep, voffA);
        if (wr == 1) PG8_BAR;
        PG8_WAIT_V(2); PG8_BAR;
        PG8_STAGE(PG8_SB(1, 0), cB + kstep, voffB); PG8_STAGE(PG8_SA(1, 0), cA + kstep, voffA); PG8_STAGE(PG8_SB(1, 1), cB + hstep + kstep, voffB);
        PG8_WAIT_V(6); PG8_BAR;
    } else {
        PG8_STAGE(PG8_SB(0, 0), cB, voffB); PG8_STAGE(PG8_SA(0, 0), cA, voffA); PG8_STAGE(PG8_SB(0, 1), cB + hstep, voffB); PG8_STAGE(PG8_SA(0, 1), cA + hstep, voffA);
        if (wr == 1) PG8_BAR;
        PG8_WAIT_V(4); PG8_BAR;
        PG8_STAGE(PG8_SB(1, 0), cB + kstep, voffB); PG8_STAGE(PG8_SA(1, 0), cA + kstep, voffA); PG8_STAGE(PG8_SB(1, 1), cB + hstep + kstep, voffB);
        PG8_WAIT_V(6); PG8_BAR;
    }
    for (;;) {
        const bool has_next = S.next(ui + 1, nxt);
        const char* nA = has_next ? (const char*)g.A + (size_t)nxt.pm * tstep : cA; const char* nB = has_next ? (const char*)g.Bt + (size_t)nxt.pn * tstep : cB;
        for (int t = 0; t < nt; t += 2) {
            const bool last = (t == nt - 2);
            const char* a1 = cA + (size_t)(t + 1) * kstep;
            const char* a2 = last ? nA : cA + (size_t)(t + 2) * kstep; const char* b2 = last ? nB : cB + (size_t)(t + 2) * kstep;
            const char* a3 = a2 + kstep; const char* b3 = b2 + kstep;
            if (last && has_next) S.a_ready(nxt);
            if constexpr (SP2) {
            PG8_LDB(B0, 0, 0); PG8_LDB(B1, 0, 1); PG8_SCHED; PG8_LDA(At, 0, 0); PG8_STAGE(PG8_SA(1, 1), a1 + hstep, voffA);
            PG8_WAIT_V(8); PG8_WAIT_L(0); PG8_BAR; PG8_MMA(0, 0, At, B0); PG8_MMA(0, 1, At, B1); PG8_BAR; PG8_SCHED;
            PG8_LDA(At, 0, 1); PG8_STAGE(PG8_SB(0, 0), b2, voffB); PG8_STAGE(PG8_SB(0, 1), b2 + hstep, voffB); PG8_STAGE(PG8_SA(0, 0), a2, voffA);
            PG8_WAIT_V(8); PG8_WAIT_L(0); PG8_BAR; PG8_MMA(1, 0, At, B0); PG8_MMA(1, 1, At, B1); PG8_BAR; PG8_SCHED;
            PG8_LDB(B0, 1, 0); PG8_LDB(B1, 1, 1); PG8_SCHED; PG8_LDA(At, 1, 0); PG8_STAGE(PG8_SA(0, 1), a2 + hstep, voffA);
            PG8_WAIT_V(8); PG8_WAIT_L(0); PG8_BAR; PG8_MMA(0, 0, At, B0); PG8_MMA(0, 1, At, B1); PG8_BAR; PG8_SCHED;
            PG8_LDA(At, 1, 1); PG8_STAGE(PG8_SB(1, 0), b3, voffB); PG8_STAGE(PG8_SB(1, 1), b3 + hstep, voffB); PG8_STAGE(PG8_SA(1, 0), a3, voffA);
            PG8_WAIT_V(8); PG8_WAIT_L(0); PG8_BAR; PG8_MMA(1, 0, At, B0); PG8_MMA(1, 1, At, B1); PG8_BAR; PG8_SCHED;
            } else {
            PG8_LDB(B0, 0, 0); PG8_SCHED; PG8_LDA(At, 0, 0); PG8_STAGE(PG8_SA(1, 1), a1 + hstep, voffA);
            PG8_WAIT_L(8); PG8_BAR; PG8_WAIT_L(0); PG8_MMA(0, 0, At, B0); PG8_BAR; PG8_SCHED;
            PG8_LDB(B1, 0, 1); PG8_STAGE(PG8_SB(0, 0), b2, voffB);
            PG8_BAR; PG8_WAIT_L(0); PG8_MMA(0, 1, At, B1); PG8_BAR;
            PG8_LDA(At, 0, 1); PG8_STAGE(PG8_SA(0, 0), a2, voffA);
            PG8_BAR; PG8_WAIT_L(0); PG8_MMA(1, 0, At, B0); PG8_BAR; PG8_SCHED;
            PG8_STAGE(PG8_SB(0, 1), b2 + hstep, voffB);
            PG8_WAIT_V(6); PG8_BAR; PG8_MMA(1, 1, At, B1); PG8_BAR;
            PG8_LDB(B0, 1, 0); PG8_SCHED; PG8_LDA(At, 1, 0); PG8_STAGE(PG8_SA(0, 1), a2 + hstep, voffA);
            PG8_WAIT_L(8); PG8_BAR; PG8_WAIT_L(0); PG8_MMA(0, 0, At, B0); PG8_BAR; PG8_SCHED;
            PG8_LDB(B1, 1, 1); PG8_STAGE(PG8_SB(1, 0), b3, voffB);
            PG8_BAR; PG8_WAIT_L(0); PG8_MMA(0, 1, At, B1); PG8_BAR;
            PG8_LDA(At, 1, 1); PG8_STAGE(PG8_SA(1, 0), a3, voffA);
            PG8_BAR; PG8_WAIT_L(0); PG8_MMA(1, 0, At, B0); PG8_BAR; PG8_SCHED;
            PG8_STAGE(PG8_SB(1, 1), b3 + hstep, voffB);
            PG8_WAIT_V(6); PG8_BAR; PG8_MMA(1, 1, At, B1); PG8_BAR;
            }
        }
        if constexpr (ALIGN_EPI) { if (wr == 0) PG8_BAR; }
        if constexpr (!Epi::AFTER_DRAIN) { E(acc, cur, wr, wc, (int)(threadIdx.x & 15u), (int)((threadIdx.x >> 4) & 3u)); S.done(cur); }
        if (!has_next) break;
#pragma unroll
        for (int a = 0; a < 2; ++a)
#pragma unroll
            for (int b = 0; b < 2; ++b)
#pragma unroll
                for (int m = 0; m < 4; ++m)
#pragma unroll
                    for (int n = 0; n < 2; ++n) acc[a][b][m][n] = (f32x4){0.f, 0.f, 0.f, 0.f};
        cur = nxt; cA = nA; cB = nB; ++ui;
        if constexpr (ALIGN_EPI) { if (wr == 1) PG8_BAR; }
    }
    PG8_WAIT_V(0);
    if constexpr (!ALIGN_EPI) { if (wr == 0) PG8_BAR; }
    PG8_BAR;
    if constexpr (Epi::AFTER_DRAIN) { E.fused(acc, cur, wr, wc, (int)(threadIdx.x & 15u), (int)((threadIdx.x >> 4) & 3u), lds, wid, (int)(threadIdx.x & 63u)); S.done(cur); }
#undef PG8_SA
#undef PG8_SB
#undef PG8_STAGE
#undef PG8_LDA
#undef PG8_LDB
#undef PG8_MMA
#undef PG8_WAIT_V
#undef PG8_WAIT_L
#undef PG8_BAR
#undef PG8_SCHED
}
}

#define LAS __attribute__((address_space(3)))
typedef unsigned short bf16;
typedef float f32x4 __attribute__((ext_vector_type(4)));
typedef float f32x2 __attribute__((ext_vector_type(2)));
typedef short bf16x8 __attribute__((ext_vector_type(8)));
typedef unsigned u32x2 __attribute__((ext_vector_type(2)));
typedef unsigned u32x4 __attribute__((ext_vector_type(4)));
typedef _Float16 h16x4 __attribute__((ext_vector_type(4)));

constexpr int NWAVES = 8, NTHR = 512;
constexpr int Mtok = 16384, Dm = 1024, Lseq = 8192, FF = 2816;
constexpr size_t MiB = 1u << 20;
constexpr size_t WS_MODS = 0;
constexpr size_t WS_APW = 256 * 1024;
constexpr size_t WS_EPW = 1024 * 1024;
constexpr size_t WS_BAR = 1792 * 1024;
constexpr size_t WS_WB = 2 * MiB;
constexpr size_t WS_WB2 = 14 * MiB;
constexpr size_t WS_XN = 22 * MiB;
constexpr size_t WS_ROT = 54 * MiB;
constexpr size_t WS_BIG = 70 * MiB;
constexpr size_t WS_H = WS_BIG;
constexpr size_t WS_G = WS_BIG;
constexpr size_t WS_Q = WS_BIG + 64 * MiB;
constexpr size_t WS_K = WS_BIG + 80 * MiB;
constexpr size_t WS_KT = WS_BIG + 96 * MiB;
constexpr size_t WS_VT = WS_BIG + 112 * MiB;
constexpr size_t WS_KV = WS_BIG + 144 * MiB;
constexpr size_t WS_XH = WS_BIG;
constexpr size_t WS_SLOC = WS_BIG + 48 * MiB;
constexpr size_t WS_YG = WS_BIG + 80 * MiB;
constexpr size_t WS_TC = WS_BIG + 112 * MiB;
constexpr size_t WS_SP = WS_BIG + 124 * MiB;
constexpr size_t WS_END = WS_BIG + 208 * MiB;

constexpr int LDS_BYTES = 135168;

__device__ __forceinline__ unsigned f2bf(float f) { unsigned u = __builtin_bit_cast(unsigned, f); return (u + 0x7fffu + ((u >> 16) & 1u)) >> 16; }
__device__ __forceinline__ unsigned pk2(float lo, float hi) { return f2bf(lo) | (f2bf(hi) << 16); }
__device__ __forceinline__ float bf2f(unsigned short h) { return __builtin_bit_cast(float, (unsigned)h << 16); }
__device__ __forceinline__ float shx(float v, int o, int lane) { return __builtin_bit_cast(float, __builtin_amdgcn_ds_bpermute((lane ^ o) << 2, __builtin_bit_cast(int, v))); }
__device__ __forceinline__ float wave_sum(float v, int lane) {
#pragma unroll
    for (int o = 1; o < 64; o <<= 1) v += shx(v, o, lane);
    return v;
}

enum { K_PRO = 0, K_ROW, K_FFN_IN, K_FFN_OUT, K_G3, K_R1, K_R2, K_R3, K_RETOUT, K_S5A, K_S5B, K_S5C, K_GLU, K_FINAL };
constexpr int MAXPH = 64;
struct Params {
    const float* x; const float* c; const int* pos; const float* ada_w; const float* ada_b; const float* norm_g;
    const float* ffn_w_in; const float* ffn_w_out; const float* ret_w_in; const float* ret_w_out;
    const float* a_re; const float* a_im; const float* b_re; const float* b_im; const float* c_re; const float* c_im;
    const float* s5_d; const float* log_dt; const float* w_glu; const float* final_g;
    float* out; unsigned char* ws;
    int nph; int pad;
    unsigned char ph[MAXPH][4];
};

typedef const __attribute__((address_space(4))) Params* KP;

__device__ __forceinline__ int map_row(int mode, int hv, int n) {
    if (mode == 1) { const int up = n >= hv ? 1 : 0, j = n - up * hv; return 256 * (j >> 7) + 128 * up + (j & 127); }
    if (mode == 2) { return n < 4096 ? n + 2048 : n - 4096; }
    return n;
}
__device__ __forceinline__ void conv_item(const float* W, int K, int N, bf16* WT, int mode, int hv, LAS float* scr, int item, int lane) {
    const int nblk = N / 32, kb = item / nblk, nb = item % nblk, k0 = 64 * kb, n0 = 32 * nb;
    float tv[32];
#pragma unroll
    for (int i = 0; i < 32; ++i) tv[i] = __builtin_nontemporal_load(&W[(size_t)(k0 + 2 * i + (lane >> 5)) * N + n0 + (lane & 31)]);
#pragma unroll
    for (int i = 0; i < 32; ++i) scr[(2 * i + (lane >> 5)) * 33 + (lane & 31)] = tv[i];
    asm volatile("s_waitcnt lgkmcnt(0)" ::: "memory");
    const int c = lane & 7;
#pragma unroll
    for (int j = 0; j < 4; ++j) { const int n = (lane >> 3) + 8 * j; const LAS float* s = scr + (8 * c) * 33 + n;
        u32x4 o; o.x = pk2(s[0 * 33], s[1 * 33]); o.y = pk2(s[2 * 33], s[3 * 33]); o.z = pk2(s[4 * 33], s[5 * 33]); o.w = pk2(s[6 * 33], s[7 * 33]);
        *(u32x4*)(WT + (size_t)map_row(mode, hv, n0 + n) * K + k0 + 8 * c) = o; }
    asm volatile("s_waitcnt lgkmcnt(0)" ::: "memory");
}
__device__ __forceinline__ void conv_job(const float* W, int K, int N, bf16* WT, int mode, int hv, LAS float* scr, int gw, int ngw, int lane) {
    const int nitems = (K / 64) * (N / 32);
    for (int it = gw; it < nitems; it += ngw) conv_item(W, K, N, WT, mode, hv, scr, it, lane);
}

__device__ __forceinline__ void row_pass(const void* xin, int in_f32, const float* gvec, const float* sh, const float* sc, bf16* XN, bf16* XH, bf16* XC, int gw, int ngw, int lane) {
    for (int m0 = gw; m0 < Mtok; m0 += 4 * ngw) {
        f32x4 v[4][4]; float s[4];
#pragma unroll
        for (int r = 0; r < 4; ++r) {
            const int m = m0 + r * ngw; const size_t ro = (size_t)(m < Mtok ? m : m0) * Dm;
            if (in_f32) {
#pragma unroll
                for (int j = 0; j < 4; ++j) v[r][j] = __builtin_nontemporal_load((const f32x4*)((const float*)xin + ro) + lane + 64 * j);
            } else {
#pragma unroll
                for (int j = 0; j < 4; ++j) v[r][j] = __builtin_convertvector(*((const h16x4*)((const bf16*)xin + ro) + lane + 64 * j), f32x4);
            }
        }
#pragma unroll
        for (int r = 0; r < 4; ++r) {
            float a = 0.f;
#pragma unroll
            for (int j = 0; j < 4; ++j) a += (v[r][j][0] * v[r][j][0] + v[r][j][1] * v[r][j][1]) + (v[r][j][2] * v[r][j][2] + v[r][j][3] * v[r][j][3]);
            s[r] = 1.0f / sqrtf(wave_sum(a, lane) * (1.0f / Dm) + 1e-6f);
        }
#pragma unroll
        for (int j = 0; j < 4; ++j) {
            const int col = 4 * lane + 256 * j;
            const f32x4 g = *(const f32x4*)(gvec + col);
#pragma unroll
            for (int r = 0; r < 4; ++r) {
                const int m = m0 + r * ngw;
                if (m < Mtok) {
                    const int b = m >> 13;
                    const f32x4 s1 = *(const f32x4*)(sc + b * 9216 + col), s0 = *(const f32x4*)(sh + b * 9216 + col);
                    const f32x4 y = (v[r][j] * s[r] * g) * (s1 + 1.0f) + s0;
                    const unsigned long long pv = (unsigned long long)pk2(y[0], y[1]) | ((unsigned long long)pk2(y[2], y[3]) << 32);
                    *((unsigned long long*)(XN + (size_t)m * Dm) + lane + 64 * j) = pv;
                    if (XC) *((h16x4*)(XC + (size_t)m * Dm) + lane + 64 * j) = __builtin_convertvector(v[r][j], h16x4);
                    if (XH) *(unsigned long long*)(XH + ((size_t)(col >> 4) * 1024 + (m >> 4)) * 384 + 16 * (m & 15) + (col & 15)) = pv;
                }
            }
        }
    }
}
__device__ __forceinline__ void final_norm(const bf16* xr_, float* outp, const float* gvec, int gw, int ngw, int lane) {
    for (int m0 = gw; m0 < Mtok; m0 += 4 * ngw) {
        f32x4 v[4][4]; float s[4];
#pragma unroll
        for (int r = 0; r < 4; ++r) {
            const int m = m0 + r * ngw; const size_t ro = (size_t)(m < Mtok ? m : m0) * Dm;
#pragma unroll
            for (int j = 0; j < 4; ++j) v[r][j] = __builtin_convertvector(*((const h16x4*)(xr_ + ro) + lane + 64 * j), f32x4);
        }
#pragma unroll
        for (int r = 0; r < 4; ++r) {
            float a = 0.f;
#pragma unroll
            for (int j = 0; j < 4; ++j) a += (v[r][j][0] * v[r][j][0] + v[r][j][1] * v[r][j][1]) + (v[r][j][2] * v[r][j][2] + v[r][j][3] * v[r][j][3]);
            s[r] = 1.0f / sqrtf(wave_sum(a, lane) * (1.0f / Dm) + 1e-6f);
        }
#pragma unroll
        for (int j = 0; j < 4; ++j) {
            const f32x4 g = *(const f32x4*)(gvec + 4 * lane + 256 * j);
#pragma unroll
            for (int r = 0; r < 4; ++r) { const int m = m0 + r * ngw; if (m < Mtok) __builtin_nontemporal_store(v[r][j] * s[r] * g, (f32x4*)(outp + (size_t)m * Dm) + lane + 64 * j); }
        }
    }
}

__device__ __forceinline__ void prologue(KP P, LAS unsigned char* lds, int bid, int G, int tid, int w, int lane) {
    float* mods = (float*)(P->ws + WS_MODS);
    LAS float* red = (LAS float*)lds;
    for (int it = bid; it < 72; it += G) {
        const int l = it / 36, cb = it % 36;
        f32x4 a0 = {0.f, 0.f, 0.f, 0.f}, a1 = {0.f, 0.f, 0.f, 0.f};
        const float* wp = P->ada_w + ((size_t)l * 1024 + 128 * w) * 9216 + 256 * cb + 4 * lane;
#pragma unroll 16
        for (int kk = 0; kk < 128; ++kk) {
            const f32x4 wv = __builtin_nontemporal_load((const f32x4*)(wp + (size_t)kk * 9216));
            const float c0 = P->c[128 * w + kk], c1 = P->c[1024 + 128 * w + kk];
            const float s0 = c0 / (1.f + __expf(-c0)), s1 = c1 / (1.f + __expf(-c1));
            a0 += wv * s0; a1 += wv * s1;
        }
#pragma unroll
        for (int i = 0; i < 4; ++i) { red[(w * 2 + 0) * 256 + 4 * lane + i] = a0[i]; red[(w * 2 + 1) * 256 + 4 * lane + i] = a1[i]; }
        __syncthreads();
        { const int b = tid >> 8, col = tid & 255; float s = 0.f;
#pragma unroll
          for (int ww = 0; ww < 8; ++ww) s += red[(ww * 2 + b) * 256 + col];
          mods[(size_t)(l * 2 + b) * 9216 + 256 * cb + col] = s + P->ada_b[l * 9216 + 256 * cb + col]; }
        __syncthreads();
    }
    if (G > 144 && bid < 72) return;
    const int gt = (G > 144 ? bid - 72 : bid) * NTHR + tid, ngt = (G > 144 ? G - 72 : G) * NTHR;
    float* rot = (float*)(P->ws + WS_ROT);
    for (int e = gt; e < Mtok * 128; e += ngt) {
        const int m = e >> 7, d = e & 127;
        double invf = 1.0, bs = 0.9305720409296990;
#pragma unroll
        for (int q = 0; q < 7; ++q) { if ((d >> q) & 1) invf *= bs; bs *= bs; }
        const double a = (double)P->pos[m] * invf;
        const double kq = __builtin_rint(a * 0.15915494309189535);
        const float fr_ = (float)__builtin_fma(a, 0.15915494309189535, -kq);
        *(f32x2*)(rot + (size_t)e * 2) = (f32x2){__builtin_amdgcn_cosf(fr_), __builtin_amdgcn_sinf(fr_)};
    }
    f32x2* apw = (f32x2*)(P->ws + WS_APW); f32x2* epw = (f32x2*)(P->ws + WS_EPW);
    for (int e = gt; e < 64 * 64 * 17; e += ngt) {
        const int t = e % 17, gp = e / 17, g = gp >> 6;
        const float dt = __expf(P->log_dt[g]);
        const float are = P->a_re[gp], aim = P->a_im[gp];
        const float mg = __expf((float)t * dt * are);
        const double an = (double)t * (double)dt * (double)aim * 0.15915494309189535;
        const float fa = (float)(an - __builtin_rint(an));
        const float pr = mg * __builtin_amdgcn_cosf(fa), pi = mg * __builtin_amdgcn_sinf(fa);
        apw[e] = (f32x2){pr, pi};
        if (t < 16) {
            const float xx = dt * are;
            const float em1 = xx * (1.f + xx * (0.5f + xx * (0.16666667f + xx * (0.041666668f + xx * 0.0083333338f))));
            const double a1 = (double)dt * (double)aim * 0.15915494309189535;
            const float f1 = (float)(a1 - __builtin_rint(a1)); const double a2 = 0.5 * a1; const float f2 = (float)(a2 - __builtin_rint(a2));
            const float c1 = __builtin_amdgcn_cosf(f1), s1 = __builtin_amdgcn_sinf(f1), sh = __builtin_amdgcn_sinf(f2);
            const float br = em1 * c1 - 2.f * sh * sh, bi = (1.f + em1) * s1;
            const float den = are * are + aim * aim;
            const float wr = (br * are + bi * aim) / den, wi = (bi * are - br * aim) / den;
            epw[gp * 16 + t] = (f32x2){pr * wr - pi * wi, pr * wi + pi * wr};
        }
    }
}

__device__ __forceinline__ void s5_build(KP P, int gt, int ngt) {
    const f32x2* apw = (const f32x2*)(P->ws + WS_APW); const f32x2* epw = (const f32x2*)(P->ws + WS_EPW);
    bf16* TC = (bf16*)(P->ws + WS_TC); bf16* SP = (bf16*)(P->ws + WS_SP);
    for (int e = gt; e < 64 * 16 * 16 * 16; e += ngt) {
        const int kp = e & 15, k = (e >> 4) & 15, d = (e >> 8) & 15, g = e >> 12;
        float acc = 0.f;
        for (int p = 0; p < 64; ++p) {
            const f32x2 E = epw[(g * 64 + p) * 16 + d];
            const float br = P->b_re[((size_t)g * 64 + p) * 16 + kp], bi = P->b_im[((size_t)g * 64 + p) * 16 + kp];
            const float zr = E.x * br - E.y * bi, zi = E.x * bi + E.y * br;
            const float cr = P->c_re[((size_t)g * 16 + k) * 64 + p], ci = P->c_im[((size_t)g * 16 + k) * 64 + p];
            acc += cr * zr - ci * zi;
        }
        const bf16 v = (bf16)f2bf(acc);
        bf16* tg = TC + (size_t)g * 256 * 384;
        for (int j = 0; j + d < 16; ++j) { const int i = j + d; tg[(16 * i + k) * 384 + 16 * j + kp] = v; }
        if (d >= 1) for (int i = 0; i + d < 16; ++i) { const int j = i + d; tg[(16 * i + k) * 384 + 16 * j + kp] = 0; }
    }
    for (int e = gt; e < 64 * 64 * 16 * 16; e += ngt) {
        const int kp = e & 15, j = (e >> 4) & 15, p = (e >> 8) & 63, g = e >> 14;
        const f32x2 E = epw[(g * 64 + p) * 16 + (15 - j)];
        const float br = P->b_re[((size_t)g * 64 + p) * 16 + kp], bi = P->b_im[((size_t)g * 64 + p) * 16 + kp];
        bf16* sg = SP + (size_t)g * 256 * 384;
        sg[(2 * p) * 384 + 16 * j + kp] = (bf16)f2bf(E.x * br - E.y * bi);
        sg[(2 * p + 1) * 384 + 16 * j + kp] = (bf16)f2bf(E.x * bi + E.y * br);
    }
    for (int e = gt; e < 64 * 256 * 192; e += ngt) {
        const int g = e / (256 * 192), r = (e / 192) & 255, cp = e % 192;
        unsigned* sg = (unsigned*)(SP + (size_t)g * 256 * 384 + (size_t)r * 384);
        if (r >= 128 || cp >= 128) sg[cp] = 0u;
    }
    for (int e = gt; e < 64 * 16 * 16 * 64; e += ngt) {
        const int p = e & 63, k = (e >> 6) & 15, i = (e >> 10) & 15, g = e >> 14;
        const f32x2 A = apw[(g * 64 + p) * 17 + i + 1];
        const float cr = P->c_re[((size_t)g * 16 + k) * 64 + p], ci = P->c_im[((size_t)g * 16 + k) * 64 + p];
        const float wr = cr * A.x - ci * A.y, wi = cr * A.y + ci * A.x;
        *(unsigned*)(TC + (size_t)g * 256 * 384 + (16 * i + k) * 384 + 256 + 2 * p) = pk2(wr, -wi);
    }
}

#define MFMA16(a, b, c) __builtin_amdgcn_mfma_f32_16x16x32_bf16((a), (b), (c), 0, 0, 0)

__device__ __forceinline__ void s5b_phase(const float* Sloc, const f32x2* apw, bf16* XH, LAS unsigned char* lds, int bid, int G, int w, int lane) {
    LAS f32x2* E = (LAS f32x2*)lds;
    for (int u = bid; u < 128; u += G) {
        const int b = u >> 6, g = u & 63, p = lane;
        const f32x2 A16 = apw[(g * 64 + p) * 17 + 16];
        const float* sp = Sloc + ((size_t)(b * 512 + 64 * w) * 64 + g) * 128 + 2 * p;
        bf16* hp = XH + ((size_t)g * 1024 + b * 512 + 64 * w) * 384 + 256 + 2 * p;
        float er = 0.f, ei = 0.f;
#pragma unroll 1
        for (int hf = 0; hf < 2; ++hf) {
            f32x2 sv[32];
#pragma unroll
            for (int q = 0; q < 32; ++q) sv[q] = *(const f32x2*)(sp + (size_t)(32 * hf + q) * 8192);
#pragma unroll
            for (int q = 0; q < 32; ++q) { const float nr = A16.x * er - A16.y * ei + sv[q].x, ni = A16.x * ei + A16.y * er + sv[q].y; er = nr; ei = ni; }
        }
        E[w * 64 + p] = (f32x2){er, ei};
        float pr = A16.x, pi = A16.y;
#pragma unroll
        for (int q = 0; q < 6; ++q) { const float nr = pr * pr - pi * pi, ni = 2.f * pr * pi; pr = nr; pi = ni; }
        __syncthreads();
        float hr = 0.f, hi = 0.f;
        for (int k = 0; k < w; ++k) { const f32x2 e = E[k * 64 + p]; const float nr = pr * hr - pi * hi + e.x, ni = pr * hi + pi * hr + e.y; hr = nr; hi = ni; }
#pragma unroll 1
        for (int hf = 0; hf < 2; ++hf) {
            f32x2 sv[32];
#pragma unroll
            for (int q = 0; q < 32; ++q) sv[q] = *(const f32x2*)(sp + (size_t)(32 * hf + q) * 8192);
#pragma unroll
            for (int q = 0; q < 32; ++q) {
                *(unsigned*)(hp + (size_t)(32 * hf + q) * 384) = pk2(hr, hi);
                const float nr = A16.x * hr - A16.y * hi + sv[q].x, ni = A16.x * hi + A16.y * hr + sv[q].y; hr = nr; hi = ni;
            }
        }
        __syncthreads();
    }
}
__device__ __forceinline__ void r1_phase(const bf16* KD, const bf16* VT, bf16* KV, LAS unsigned char* lds, int bid, int G, int w, int lane_) {
    for (int u = bid; u < 256; u += G) {
        int lane = lane_; asm volatile("" : "+v"(lane));
        const int fr = lane & 15, fq = lane >> 4;
        const int h = u >> 6, n = u & 63;
        const char* kdu = (const char*)(KD + ((size_t)(8 * n) * 32 + 8 * h) * 512);
        const char* vtu = (const char*)(VT + ((size_t)(32 * h) * 256 + 4 * n) * 512);
#pragma unroll
        for (int q = 0; q < 8; ++q)
            __builtin_amdgcn_global_load_lds((const unsigned*)(kdu + (size_t)(w * 32 + q) * 1024 + lane * 16), (LAS unsigned*)(lds + (8 * w + q) * 1024), 16, 0, 0);
#define R1_DMA(p, bufoff) do { _Pragma("unroll") for (int q_ = 0; q_ < 4; ++q_) \
        __builtin_amdgcn_global_load_lds((const unsigned*)(vtu + (size_t)(8 * (p) + w) * 262144 + q_ * 1024 + lane * 16), (LAS unsigned*)(lds + (bufoff) + (4 * w + q_) * 1024), 16, 0, 0); } while (0)
        R1_DMA(0, 65536);
        asm volatile("s_waitcnt vmcnt(0)" ::: "memory");
        __syncthreads();
        bf16x8 af[2][4];
#pragma unroll
        for (int rbl = 0; rbl < 2; ++rbl)
#pragma unroll
            for (int ks = 0; ks < 4; ++ks) {
                const LAS unsigned short* base = (const LAS unsigned short*)(lds + ((2 * ks + (fq >> 1)) * 8 + w) * 1024) + ((2 * rbl + (fr >> 3)) * 16 + 8 * (fq & 1)) * 8 + (fr & 7);
                bf16x8 v;
#pragma unroll
                for (int jj = 0; jj < 8; ++jj) v[jj] = (short)base[jj * 8];
                af[rbl][ks] = v;
            }
#pragma unroll 1
        for (int p = 0; p < 4; ++p) {
            LAS unsigned char* buf = lds + 65536 + (p & 1) * 32768;
            if (p + 1 < 4) R1_DMA(p + 1, 65536 + ((p + 1) & 1) * 32768);
            f32x4 acc[2][8];
#pragma unroll
            for (int rbl = 0; rbl < 2; ++rbl)
#pragma unroll
                for (int cb = 0; cb < 8; ++cb) acc[rbl][cb] = (f32x4){0.f, 0.f, 0.f, 0.f};
#pragma unroll
            for (int cb = 0; cb < 8; ++cb)
#pragma unroll
                for (int ks = 0; ks < 4; ++ks) {
                    const bf16x8 vf = *(const LAS bf16x8*)(buf + (cb * 4 + ks) * 1024 + lane * 16);
                    acc[0][cb] = MFMA16(af[0][ks], vf, acc[0][cb]); acc[1][cb] = MFMA16(af[1][ks], vf, acc[1][cb]);
                }
#pragma unroll
            for (int rbl = 0; rbl < 2; ++rbl)
#pragma unroll
                for (int cb = 0; cb < 8; ++cb) {
                    const f32x4 a = acc[rbl][cb];
                    *(u32x2*)(KV + (size_t)u * 131072 + ((8 * p + cb) * 8 + w) * 512 + ((2 * rbl + (fq >> 1)) * 16 + fr) * 8 + 4 * (fq & 1)) = (u32x2){pk2(a[0], a[1]), pk2(a[2], a[3])};
                }
            asm volatile("s_waitcnt vmcnt(0)" ::: "memory");
            __syncthreads();
        }
    }
}
__device__ __forceinline__ void r2_phase(bf16* KV, int gt, int ngt) {
    for (int it = gt; it < 131072; it += ngt) {
        const int h = it >> 15, rem = it & 32767;
        const float gC = exp2f(128.0f * log2f(1.0f - exp2f(-5.0f - (float)h)));
        float s0 = 0.f, s1 = 0.f, s2 = 0.f, s3 = 0.f;
        bf16* base = KV + (size_t)h * 64 * 131072 + (size_t)rem * 4;
        for (int n0 = 0; n0 < 64; n0 += 8) {
            u32x2 kv[8];
#pragma unroll
            for (int q = 0; q < 8; ++q) kv[q] = *(const u32x2*)(base + (size_t)(n0 + q) * 131072);
#pragma unroll
            for (int q = 0; q < 8; ++q) {
                *(u32x2*)(base + (size_t)(n0 + q) * 131072) = (u32x2){pk2(s0, s1), pk2(s2, s3)};
                s0 = s0 * gC + __builtin_bit_cast(float, kv[q].x << 16); s1 = s1 * gC + __builtin_bit_cast(float, kv[q].x & 0xffff0000u);
                s2 = s2 * gC + __builtin_bit_cast(float, kv[q].y << 16); s3 = s3 * gC + __builtin_bit_cast(float, kv[q].y & 0xffff0000u);
            }
        }
    }
}
__device__ __forceinline__ const char* r3_stage_src(int s, const char* kb, const char* st, const char* vt, int c) {
    const int slot = c >> 6, lp = (c & 63) * 16;
    if (s < 2) return kb + (size_t)((4 * s + (slot >> 3)) * 32 + (slot & 7)) * 1024 + lp;
    if (s < 10) return st + (size_t)(s - 2) * 32768 + (size_t)c * 16;
    return vt + (size_t)slot * 262144 + (size_t)(s - 10) * 1024 + lp;
}
__device__ __forceinline__ void r3_phase(const bf16* Q, const bf16* Kb, const bf16* VT, const bf16* ST, bf16* Gb, LAS unsigned char* lds, int bid, int G, int tid_, int w, int lane_) {
    LAS bf16* sw = (LAS bf16*)(lds + 65536 + w * 4352);
    LAS bf16* ow = (LAS bf16*)(lds + w * 8448);
    for (int u = bid; u < 256; u += G) {
        int tid = tid_, lane = lane_; asm volatile("" : "+v"(tid), "+v"(lane));
        const int fr = lane & 15, fq = lane >> 4;
        const int h = u >> 6, n = u & 63;
        const float lg = log2f(1.0f - exp2f(-5.0f - (float)h));
        const char* kbu = (const char*)(Kb + ((size_t)(8 * n) * 32 + 8 * h) * 512);
        const char* stu = (const char*)(ST + (size_t)u * 131072);
        const char* vtu = (const char*)(VT + ((size_t)(32 * h) * 256 + 4 * n) * 512);
        bf16x8 qf[8];
        { const char* qtu = (const char*)(Q + ((size_t)(8 * n + w) * 32 + 8 * h) * 512);
#pragma unroll
          for (int ks = 0; ks < 8; ++ks) qf[ks] = *(const bf16x8*)(qtu + ks * 1024 + lane * 16); }
#define R3_DMA(sg, bufoff) do { _Pragma("unroll") for (int q_ = 0; q_ < 4; ++q_) \
        __builtin_amdgcn_global_load_lds((const unsigned*)r3_stage_src((sg), kbu, stu, vtu, (4 * w + q_) * 64 + lane), (LAS unsigned*)(lds + (bufoff) + (4 * w + q_) * 1024), 16, 0, 0); } while (0)
        R3_DMA(0, 0);
        asm volatile("s_waitcnt vmcnt(0)" ::: "memory");
        __syncthreads();
        const int jbmax = w | 1, ksmax = w >> 1;
        f32x4 as[8];
#pragma unroll
        for (int jb = 0; jb < 8; ++jb) as[jb] = (f32x4){0.f, 0.f, 0.f, 0.f};
        f32x4 o[32];
#pragma unroll
        for (int s = 0; s < 14; ++s) {
            LAS unsigned char* buf = lds + (s & 1) * 32768;
            if (s + 1 < 14) R3_DMA(s + 1, ((s + 1) & 1) * 32768);
            if (s < 2) {
#pragma unroll
                for (int jl = 0; jl < 4; ++jl)
                    if (4 * s + jl <= jbmax) {
#pragma unroll
                        for (int ks = 0; ks < 8; ++ks) { const bf16x8 kf = *(const LAS bf16x8*)(buf + (jl * 8 + ks) * 1024 + lane * 16); as[4 * s + jl] = MFMA16(qf[ks], kf, as[4 * s + jl]); }
                        asm volatile("" ::: "memory");
                    }
                if (s == 1) {
#pragma unroll
                    for (int jb = 0; jb < 8; ++jb)
                        if (jb <= jbmax) {
#pragma unroll
                            for (int ii = 0; ii < 4; ++ii) {
                                const int i = 16 * w + 4 * fq + ii, j = 16 * jb + fr;
                                const float v = (i >= j) ? as[jb][ii] * __builtin_amdgcn_exp2f(lg * (float)(i - 127)) : 0.f;
                                sw[(4 * fq + ii) * 136 + j] = (bf16)f2bf(v);
                            }
                        }
                }
            } else if (s < 10) {
                if (s == 2) {
#pragma unroll
                    for (int eb = 0; eb < 32; ++eb) o[eb] = (f32x4){0.f, 0.f, 0.f, 0.f};
                }
#pragma unroll
                for (int el = 0; el < 4; ++el)
#pragma unroll
                    for (int ks = 0; ks < 8; ++ks) { const bf16x8 sf = *(const LAS bf16x8*)(buf + (el * 8 + ks) * 1024 + lane * 16); o[4 * (s - 2) + el] = MFMA16(qf[ks], sf, o[4 * (s - 2) + el]); if ((ks & 3) == 3) asm volatile("" ::: "memory"); }
                if (s == 9) {
                    float qd[4];
#pragma unroll
                    for (int ii = 0; ii < 4; ++ii) qd[ii] = __builtin_amdgcn_exp2f(lg * (float)(16 * w + 4 * fq + ii + 1));
#pragma unroll
                    for (int eb = 0; eb < 32; ++eb)
#pragma unroll
                        for (int ii = 0; ii < 4; ++ii) o[eb][ii] *= qd[ii];
                }
            } else {
                if (s - 10 <= ksmax) {
                    const bf16x8 af = *(const LAS bf16x8*)(sw + fr * 136 + 32 * (s - 10) + 8 * fq);
#pragma unroll
                    for (int eb = 0; eb < 32; ++eb) { const bf16x8 vf = *(const LAS bf16x8*)(buf + eb * 1024 + lane * 16); o[eb] = MFMA16(af, vf, o[eb]); if ((eb & 7) == 7) asm volatile("" ::: "memory"); }
                }
            }
            asm volatile("s_waitcnt vmcnt(0)" ::: "memory");
            __syncthreads();
        }
        float mean[4], rstd[4];
#pragma unroll
        for (int ii = 0; ii < 4; ++ii) {
            float sm = 0.f;
#pragma unroll
            for (int eb = 0; eb < 32; ++eb) sm += o[eb][ii];
            sm += shx(sm, 1, lane); sm += shx(sm, 2, lane); sm += shx(sm, 4, lane); sm += shx(sm, 8, lane);
            const float mu = sm * (1.0f / 512.0f); float q = 0.f;
#pragma unroll
            for (int eb = 0; eb < 32; ++eb) { const float dd = o[eb][ii] - mu; q += dd * dd; }
            q += shx(q, 1, lane); q += shx(q, 2, lane); q += shx(q, 4, lane); q += shx(q, 8, lane);
            mean[ii] = mu; rstd[ii] = __builtin_amdgcn_rsqf(q * (1.0f / 512.0f) + 1e-5f);
        }
#pragma unroll
        for (int hf = 0; hf < 2; ++hf) {
#pragma unroll
            for (int e2 = 0; e2 < 16; ++e2)
#pragma unroll
                for (int ii = 0; ii < 4; ++ii) { ow[(4 * fq + ii) * 264 + 16 * e2 + fr] = (bf16)f2bf((o[16 * hf + e2][ii] - mean[ii]) * rstd[ii]); if (ii == 3 && (e2 & 3) == 3) asm volatile("" ::: "memory"); }
            __syncthreads();
#pragma unroll 2
            for (int q = 0; q < 8; ++q) {
                const int c = lane + 64 * q, row = c >> 5, c8 = c & 31;
                const u32x4 ov = *(const LAS u32x4*)(ow + row * 264 + 8 * c8);
                bf16* gp = Gb + (size_t)(128 * n + 16 * w + row) * 2048 + 512 * h + 256 * hf + 8 * c8;
                const u32x4 gv = *(const u32x4*)gp;
                u32x4 r;
#pragma unroll
                for (int t = 0; t < 4; ++t) {
                    const float a0 = __builtin_bit_cast(float, ov[t] << 16) * __builtin_bit_cast(float, gv[t] << 16);
                    const float a1 = __builtin_bit_cast(float, ov[t] & 0xffff0000u) * __builtin_bit_cast(float, gv[t] & 0xffff0000u);
                    r[t] = pk2(a0, a1);
                }
                *(u32x4*)gp = r;
            }
            __syncthreads();
        }
    }
}

#define XB_TMO      128
#define XB_XCNT(j)  (256  + 64 * (j))
#define XB_XSUB(j)  (1280 + 64 * (j))
#define XB_XGEN(j)  (2304 + 64 * (j))
#define XB_TOP      3328
#define XB_TOPGEN   3392
#define XCD_BAR_WORDS 3456
#define XB_SPIN_CAP (1u << 18)

__device__ __forceinline__ unsigned xb_ld(unsigned* p)              { return __hip_atomic_load(p, __ATOMIC_RELAXED, __HIP_MEMORY_SCOPE_AGENT); }
__device__ __forceinline__ unsigned xb_add(unsigned* p, unsigned v) { return __hip_atomic_fetch_add(p, v, __ATOMIC_RELAXED, __HIP_MEMORY_SCOPE_AGENT); }
__device__ __forceinline__ unsigned xb_xcc_id() { return (unsigned)__builtin_amdgcn_s_getreg((3 << 11) | 20) & 0xFu; }
#define XB_SPIN(cond, bar) do { unsigned _sp = 0; while (cond) { __builtin_amdgcn_s_sleep(1); \
    if ((++_sp & 255u) == 0u) { if (xb_ld(&(bar)[XB_TMO])) break; if (_sp > XB_SPIN_CAP) { atomicAdd(&(bar)[XB_TMO], 1u); break; } } } } while (0)

struct XcdBarrier {
    unsigned* bar; unsigned x;
    volatile LAS unsigned* st;
};

__device__ __forceinline__ XcdBarrier xcd_barrier_post(unsigned* bar, volatile LAS unsigned* st) {
    XcdBarrier b; b.bar = bar; b.x = xb_xcc_id(); b.st = st;
    if (threadIdx.x == 0) (void)xb_add(&bar[XB_XCNT(b.x)], 1u);
    return b;
}
__device__ __forceinline__ void xcd_barrier_complete(unsigned* bar, unsigned x, unsigned& nloc, unsigned& nx) {
    const unsigned G = gridDim.x * gridDim.y * gridDim.z;
    unsigned sum, cnt, mine, sp = 0u;
    for (;;) {
        sum = 0u; cnt = 0u; mine = 0u;
#pragma unroll
        for (unsigned j = 0; j < 16; ++j) { const unsigned c = xb_ld(&bar[XB_XCNT(j)]); sum += c; cnt += (c > 0u) ? 1u : 0u; mine = (j == x) ? c : mine; }
        if (sum == G) break;
        __builtin_amdgcn_s_sleep(1);
        if ((++sp & 255u) == 0u) { if (xb_ld(&bar[XB_TMO])) break; if (sp > XB_SPIN_CAP) { atomicAdd(&bar[XB_TMO], 1u); break; } }
    }
    nloc = mine > 0u ? mine : 1u; nx = cnt > 0u ? cnt : 1u;
}

__device__ __forceinline__ void xcd_barrier(const XcdBarrier& b) {
    asm volatile("s_waitcnt vmcnt(0)" ::: "memory");
    __syncthreads();
    if (threadIdx.x == 0) {
        unsigned* bar = b.bar;
        __builtin_amdgcn_s_waitcnt(0);
        unsigned nloc = b.st[0], nx = b.st[1];
        if (nloc == 0u) { xcd_barrier_complete(bar, b.x, nloc, nx); b.st[0] = nloc; b.st[1] = nx; }
        const unsigned old = xb_add(&bar[XB_XSUB(b.x)], 1u);
        const unsigned gen = old / nloc;
        if (old + 1u == (gen + 1u) * nloc) {
            __builtin_amdgcn_fence(__ATOMIC_RELEASE, "agent");
            asm volatile("s_waitcnt vmcnt(0)" ::: "memory");
            const unsigned og = xb_add(&bar[XB_TOP], 1u);
            const unsigned tg = og / nx;
            if (og + 1u == (tg + 1u) * nx) xb_add(&bar[XB_TOPGEN], 1u);
            else XB_SPIN(xb_ld(&bar[XB_TOPGEN]) == tg, bar);
            __builtin_amdgcn_fence(__ATOMIC_ACQUIRE, "agent");
            xb_add(&bar[XB_XGEN(b.x)], 1u);
            asm volatile("s_waitcnt vmcnt(0)" ::: "memory");
        } else {
            XB_SPIN(xb_ld(&bar[XB_XGEN(b.x)]) == gen, bar);
            __builtin_amdgcn_fence(__ATOMIC_ACQUIRE, "agent");
            asm volatile("s_waitcnt vmcnt(0)" ::: "memory");
        }
    }
    __syncthreads();
}

__global__ void __launch_bounds__(NTHR, 2) fwd_megakernel(Params P) {
    extern __shared__ __attribute__((aligned(16))) unsigned char lds_raw[];
    LAS unsigned char* lds0 = (LAS unsigned char*)lds_raw;
    cg::grid_group grid = cg::this_grid();
    { volatile LAS unsigned* stw = (volatile LAS unsigned*)(lds0 + 131072 + 256); if (threadIdx.x < 4) stw[threadIdx.x] = 0u; }
    __syncthreads();
    (void)xcd_barrier_post((unsigned*)(P.ws + WS_BAR), (volatile LAS unsigned*)(lds0 + 131072 + 256));
    const int nph = P.nph;
    {
        KP Q0 = (KP)__builtin_amdgcn_kernarg_segment_ptr(); asm volatile("" : "+s"(Q0));
        int tid0 = threadIdx.x; asm volatile("" : "+v"(tid0));
        prologue(Q0, lds0, (int)blockIdx.x, (int)gridDim.x, tid0, __builtin_amdgcn_readfirstlane(tid0 >> 6), tid0 & 63);
        XcdBarrier xb; xb.bar = (unsigned*)(Q0->ws + WS_BAR); xb.x = xb_xcc_id(); xb.st = (volatile LAS unsigned*)(lds0 + 131072 + 256); xcd_barrier(xb);
    }
    for (int ph = 1; ph < nph; ++ph) {
        KP Q = (KP)__builtin_amdgcn_kernarg_segment_ptr(); asm volatile("" : "+s"(Q));
        unsigned char* ws = Q->ws; asm volatile("" : "+s"(ws));
        int bid = blockIdx.x, G = gridDim.x; asm volatile("" : "+s"(bid), "+s"(G));
        LAS unsigned char* lds = lds0; asm volatile("" : "+s"(lds));
#define TLW int tid = threadIdx.x; asm volatile("" : "+v"(tid)); const int lane = tid & 63, w = __builtin_amdgcn_readfirstlane(tid >> 6); (void)lane; (void)w;
#define gw (bid * NWAVES + w)
#define ngw (G * NWAVES)
#define gt (bid * NTHR + tid)
#define ngt (G * NTHR)
#define mods ((float*)(ws + WS_MODS))
#define XN ((bf16*)(ws + WS_XN))
#define XR ((bf16*)Q->out)
#define XF ((bf16*)(ws + WS_BIG + 100 * MiB))
#define scr ((LAS float*)(lds + w * 8704))
#define modl (mods + (size_t)l * 2 * 9216)
        const int kind = Q->ph[ph][0], l = Q->ph[ph][1], sub = Q->ph[ph][2], b = Q->ph[ph][3];
        switch (kind) {
        case K_ROW: { TLW
            if (sub != 1) {
                const int fi = l * 2 + (sub >> 1);
                conv_job(Q->ffn_w_in + (size_t)fi * 1024 * 5632, 1024, 5632, (bf16*)(ws + WS_WB), 1, 2816, scr, gw, ngw, lane);
            } else if (l == 0) {
                conv_job(Q->ret_w_in, 1024, 6144, (bf16*)(ws + WS_WB), 2, 0, scr, gw, ngw, lane);
                conv_job(Q->ret_w_out, 2048, 1024, (bf16*)(ws + WS_WB2), 0, 0, scr, gw, ngw, lane);
            } else {
                conv_job(Q->w_glu, 1024, 2048, (bf16*)(ws + WS_WB), 1, 1024, scr, gw, ngw, lane);
                s5_build(Q, gt, ngt);
            }
            const void* xin = (l == 0 && sub == 0) ? (const void*)Q->x : (const void*)XR; const int in_f32 = (l == 0 && sub == 0) ? 1 : 0;
            row_pass(xin, in_f32, Q->norm_g + (size_t)(l * 3 + sub) * 1024, modl + 3072 * sub, modl + 3072 * sub + 1024, XN, (l == 1 && sub == 1) ? (bf16*)(ws + WS_XH) : (bf16*)nullptr, (l == 0 && sub == 0) ? XR : (bf16*)nullptr, gw, ngw, lane);
        } break;
        case K_FFN_IN: {
            pg8::Gemm g{XN, (const bf16*)(ws + WS_WB), Mtok, 2 * FF, Dm}; pg8::StaticOrder S; S.init(Mtok, 2 * FF, G, bid);
            pg8::EpiSwiGLU E{(bf16*)(ws + WS_H), FF};
            pg8::gemm_phase<pg8::EpiSwiGLU, pg8::StaticOrder, true, true>(lds, g, S, E);
            { TLW
              const int fi = l * 2 + (sub >> 1);
              if (G == 256) { if (bid >= 128) conv_job(Q->ffn_w_out + (size_t)fi * 2816 * 1024, 2816, 1024, (bf16*)(ws + WS_WB2), 0, 0, scr, (bid - 128) * NWAVES + w, 128 * NWAVES, lane); }
              else conv_job(Q->ffn_w_out + (size_t)fi * 2816 * 1024, 2816, 1024, (bf16*)(ws + WS_WB2), 0, 0, scr, gw, ngw, lane); }
        } break;
        case K_FFN_OUT: case K_RETOUT: {
            const bool isf = kind == K_FFN_OUT;
            pg8::Gemm g{isf ? (const bf16*)(ws + WS_H) : (const bf16*)(ws + WS_G), (const bf16*)(ws + WS_WB2), Mtok, Dm, isf ? FF : 2048}; pg8::StaticOrder S; S.init(Mtok, Dm, G, bid);
            pg8::EpiResid E{XR, (isf && l == 1 && sub == 2) ? XF : XR, modl + 3072 * sub + 2048, isf ? 0.5f : 1.0f};
            pg8::gemm_phase<pg8::EpiResid, pg8::StaticOrder, true, true>(lds, g, S, E);
        } break;
        case K_G3: {
            const float* rot = (const float*)(ws + WS_ROT) + (size_t)b * Lseq * 256;
            { pg8::Gemm g{XN + (size_t)b * Lseq * Dm, (const bf16*)(ws + WS_WB), Lseq, 4096, Dm}; pg8::StaticOrder S; S.init(Lseq, 4096, G, bid);
              pg8::EpiRet3a E{(bf16*)(ws + WS_G) + (size_t)b * Lseq * 2048, (bf16*)(ws + WS_Q), (bf16*)(ws + WS_K), (bf16*)(ws + WS_KT), rot};
              pg8::gemm_phase<pg8::EpiRet3a, pg8::StaticOrder, true, true>(lds, g, S, E); }
            { pg8::Gemm g{(const bf16*)(ws + WS_WB) + (size_t)4096 * Dm, XN + (size_t)b * Lseq * Dm, 2048, Lseq, Dm}; pg8::StaticOrder S; S.init(2048, Lseq, G, bid);
              pg8::EpiRet3b E{(bf16*)(ws + WS_VT)};
              pg8::gemm_phase<pg8::EpiRet3b, pg8::StaticOrder, true, true>(lds, g, S, E); }
        } break;
        case K_R1: { TLW r1_phase((const bf16*)(ws + WS_KT), (const bf16*)(ws + WS_VT), (bf16*)(ws + WS_KV), lds, bid, G, w, lane); } break;
        case K_R2: { TLW r2_phase((bf16*)(ws + WS_KV), gt, ngt); } break;
        case K_R3: { TLW r3_phase((const bf16*)(ws + WS_Q), (const bf16*)(ws + WS_KT), (const bf16*)(ws + WS_VT), (const bf16*)(ws + WS_KV), (bf16*)(ws + WS_G) + (size_t)b * Lseq * 2048, lds, bid, G, tid, w, lane); } break;
        case K_S5A: {
            pg8::Gemm g{(const bf16*)(ws + WS_XH), (const bf16*)(ws + WS_SP), 65536, 256, 384}; pg8::S5Order S{G, bid};
            pg8::EpiS5A E{(float*)(ws + WS_SLOC)};
            pg8::gemm_phase<pg8::EpiS5A, pg8::S5Order, true, true>(lds, g, S, E);
        } break;
        case K_S5B: { TLW s5b_phase((const float*)(ws + WS_SLOC), (const f32x2*)(ws + WS_APW), (bf16*)(ws + WS_XH), lds, bid, G, w, lane); } break;
        case K_S5C: {
            pg8::Gemm g{(const bf16*)(ws + WS_XH), (const bf16*)(ws + WS_TC), 65536, 256, 384}; pg8::S5Order S{G, bid};
            pg8::EpiS5C E{XN, Q->s5_d, (bf16*)(ws + WS_YG)};
            pg8::gemm_phase<pg8::EpiS5C, pg8::S5Order, true, true>(lds, g, S, E);
        } break;
        case K_GLU: {
            pg8::Gemm g{(const bf16*)(ws + WS_YG), (const bf16*)(ws + WS_WB), Mtok, 2048, Dm}; pg8::StaticOrder S; S.init(Mtok, 2048, G, bid);
            pg8::EpiGLU E{XR, modl + 3072 + 2048};
            pg8::gemm_phase<pg8::EpiGLU, pg8::StaticOrder, true, true>(lds, g, S, E);
        } break;
        case K_FINAL: { TLW final_norm(XF, Q->out, Q->final_g, gw, ngw, lane); } break;
        default: break;
        }
        if (ph + 1 < nph) { if (nph > MAXPH) grid.sync();   else { XcdBarrier xb; xb.bar = (unsigned*)(ws + WS_BAR); xb.x = xb_xcc_id(); xb.st = (volatile LAS unsigned*)(lds + 131072 + 256); xcd_barrier(xb); } }
    }
}

#undef TLW
#undef gw
#undef ngw
#undef gt
#undef ngt
#undef mods
#undef XN
#undef XR
#undef XF
#undef scr
#undef modl
extern "C" void kernel_launch(void* const* d_in, const int* in_sizes, int n_in, void* d_out, int out_size, void* d_ws, size_t ws_size, hipStream_t stream) {
    static int grid = 0;
    if (grid == 0) {
        if (n_in != 20 || in_sizes[0] != Mtok * Dm || out_size != Mtok * Dm || ws_size < WS_END) {
            fprintf(stderr, "kernel_launch: unexpected problem (n_in %d, in0 %d, out %d, ws %zu, need %zu); nothing launched\n", n_in, n_in > 0 ? in_sizes[0] : -1, out_size, ws_size, (size_t)WS_END);
            grid = -1; return;
        }
        int dev = 0, cus = 0, per_cu = 0;
        hipGetDevice(&dev);
        hipDeviceGetAttribute(&cus, hipDeviceAttributeMultiprocessorCount, dev);
        hipFuncSetAttribute((const void*)fwd_megakernel, hipFuncAttributeMaxDynamicSharedMemorySize, LDS_BYTES);
        hipOccupancyMaxActiveBlocksPerMultiprocessor(&per_cu, (const void*)fwd_megakernel, NTHR, LDS_BYTES);
        if (per_cu < 1) { fprintf(stderr, "kernel_launch: occupancy query reports %d blocks per CU; nothing launched\n", per_cu); grid = -1; return; }
        grid = cus;
        fprintf(stderr, "kernel_launch: grid %d (per_cu %d), ws %zu\n", grid, per_cu, ws_size);
    }
    if (grid < 0) return;
    Params p{};
    p.x = (const float*)d_in[0]; p.c = (const float*)d_in[1]; p.pos = (const int*)d_in[2]; p.ada_w = (const float*)d_in[3]; p.ada_b = (const float*)d_in[4];
    p.norm_g = (const float*)d_in[5]; p.ffn_w_in = (const float*)d_in[6]; p.ffn_w_out = (const float*)d_in[7]; p.ret_w_in = (const float*)d_in[8]; p.ret_w_out = (const float*)d_in[9];
    p.a_re = (const float*)d_in[10]; p.a_im = (const float*)d_in[11]; p.b_re = (const float*)d_in[12]; p.b_im = (const float*)d_in[13]; p.c_re = (const float*)d_in[14]; p.c_im = (const float*)d_in[15];
    p.s5_d = (const float*)d_in[16]; p.log_dt = (const float*)d_in[17]; p.w_glu = (const float*)d_in[18]; p.final_g = (const float*)d_in[19];
    p.out = (float*)d_out; p.ws = (unsigned char*)d_ws;
    int n = 0;
    auto add = [&](int k, int l, int s, int b) { p.ph[n][0] = (unsigned char)k; p.ph[n][1] = (unsigned char)l; p.ph[n][2] = (unsigned char)s; p.ph[n][3] = (unsigned char)b; ++n; };
#ifndef EXP
#define EXP 0
#endif
    const int rPRO = (EXP == 1) ? 2 : 1, rROW = (EXP == 1) ? 2 : 1, rRET = (EXP == 2) ? 2 : 1, rS5 = (EXP == 3) ? 2 : 1, rFIN = (EXP == 4) ? 2 : 1;
    for (int r = 0; r < rPRO; ++r) add(K_PRO, 0, 0, 0);
    for (int l = 0; l < 2; ++l)
        for (int s = 0; s < 3; ++s) {
            for (int r = 0; r < rROW; ++r) add(K_ROW, l, s, 0);
            if (s != 1) { for (int r = 0; r < rFIN; ++r) add(K_FFN_IN, l, s, 0); add(K_FFN_OUT, l, s, 0); }
            else if (l == 0) { for (int b = 0; b < 2; ++b) for (int r = 0; r < rRET; ++r) { add(K_G3, 0, 1, b); add(K_R1, 0, 1, b); add(K_R2, 0, 1, b); add(K_R3, 0, 1, b); } add(K_RETOUT, 0, 1, 0); }
            else { for (int r = 0; r < rS5; ++r) add(K_S5A, 1, 1, 0); for (int r = 0; r < rS5; ++r) add(K_S5B, 1, 1, 0); for (int r = 0; r < rS5; ++r) add(K_S5C, 1, 1, 0); add(K_GLU, 1, 1, 0); }
        }
    add(K_FINAL, 0, 0, 0);
    p.nph = n;
    hipMemsetAsync((char*)d_ws + WS_BAR, 0, 16384, stream);
    void* args[] = {&p};
    hipError_t e = hipLaunchCooperativeKernel((const void*)fwd_megakernel, dim3(grid), dim3(NTHR), args, LDS_BYTES, stream);
    if (e != hipSuccess) fprintf(stderr, "kernel_launch: cooperative launch failed: %s (grid %d)\n", hipGetErrorString(e), grid);
}
```

```cpp
#include <hip/hip_runtime.h>
#include <hip/hip_cooperative_groups.h>
#include <cstdio>
#include <cstdint>
namespace cg = cooperative_groups;
namespace pg8 {
#define PG8_LAS __attribute__((address_space(3)))
typedef unsigned short bf16_t;
typedef short bf16x8 __attribute__((ext_vector_type(8)));
typedef float f32x4 __attribute__((ext_vector_type(4)));
typedef unsigned u32x4 __attribute__((ext_vector_type(4)));
constexpr int BM = 256, BK = 64, HALF = 128, HTB = HALF * BK * 2  , STAGE_BYTES = 8 * HTB, NXCD = 8, WGM = 8;

__host__ __device__ __forceinline__ int lds_byte(int r, int c) { const int st = (r >> 4) * 2 + (c >> 5), rr = r & 15, cc = c & 31, ob = rr * 64 + cc * 2; return st * 1024 + (ob ^ (((ob >> 9) & 1) << 5)); }
__host__ __device__ __forceinline__ void stage_rc(int b, int& R, int& C) { const int st = b / 1024, sb = b % 1024, swz = sb ^ (((sb >> 9) & 1) << 5); R = (st >> 1) * 16 + swz / 64; C = (st & 1) * 32 + (swz % 64) / 2; }
__host__ __device__ __forceinline__ int perm32(int rho) { const int n = rho >> 4, i = rho & 15; return 8 * (i >> 2) + 4 * n + (i & 3); }

struct Unit { int pm, pn; };
struct Gemm { const bf16_t* A; const bf16_t* Bt; int M, N, K; };

struct StaticOrder {
    int nM, nN, nwg, G, c;
    __host__ __device__ void init(int M, int N, int G_, int c_) { nM = M / BM; nN = N / BM; nwg = nM * nN; G = G_; c = c_; }
    __host__ __device__ bool next(int i, Unit& u) const {
        const long L = (long)i * G + c; if (L >= nwg) return false;
        int wgid = (int)L; { const int q = nwg / NXCD, r = nwg % NXCD, xcd = wgid % NXCD, off = wgid / NXCD; wgid = (xcd < r ? xcd * (q + 1) : r * (q + 1) + (xcd - r) * q) + off; }
        const int nig = WGM * nN, gid = wgid / nig, fm = gid * WGM, gsz = (nM - fm) < WGM ? (nM - fm) : WGM;
        u.pm = fm + ((wgid % nig) % gsz); u.pn = (wgid % nig) / gsz; return true;
    }
    __device__ __forceinline__ void a_ready(const Unit&) const {}
    __device__ __forceinline__ void done(const Unit&) const {}
};
__device__ __forceinline__ unsigned cvt_pk_bf16(float lo, float hi) { unsigned r; asm volatile("v_cvt_pk_bf16_f32 %0, %1, %2" : "=v"(r) : "v"(lo), "v"(hi)); return r; }
typedef float f32x2 __attribute__((ext_vector_type(2)));
typedef unsigned u32x2 __attribute__((ext_vector_type(2)));
typedef _Float16 h16x4 __attribute__((ext_vector_type(4)));
__device__ __forceinline__ float silu_f(float v) { return v * __builtin_amdgcn_rcpf(1.f + __expf(-v)); }
__device__ __forceinline__ float sigm_f(float v) { return __builtin_amdgcn_rcpf(1.f + __expf(-v)); }
__device__ __forceinline__ u32x4 pack8(f32x4 a, f32x4 b) { u32x4 w; w.x = cvt_pk_bf16(a[0], a[1]); w.y = cvt_pk_bf16(a[2], a[3]); w.z = cvt_pk_bf16(b[0], b[1]); w.w = cvt_pk_bf16(b[2], b[3]); return w; }

struct EpiSwiGLU {
    static constexpr bool PERM = true, AFTER_DRAIN = false;
    bf16_t* O; int ldc;
    __device__ __forceinline__ void operator()(const f32x4 (&acc)[2][2][4][2], const Unit& u, int wr, int wc, int fr, int fq) const {
        asm volatile("" : "+v"(fr), "+v"(fq));
        const int row0 = u.pm * BM + wr * 64 + fr, col0 = u.pn * HALF + wc * 32 + 8 * fq;
#pragma unroll
        for (int ai = 0; ai < 2; ++ai)
#pragma unroll
            for (int m = 0; m < 4; ++m) {
                bf16_t* rowp = O + (size_t)(row0 + ai * HALF + m * 16) * ldc + col0;
                f32x4 o0, o1;
#pragma unroll
                for (int i = 0; i < 4; ++i) { o0[i] = silu_f(acc[ai][0][m][0][i]) * acc[ai][1][m][0][i]; o1[i] = silu_f(acc[ai][0][m][1][i]) * acc[ai][1][m][1][i]; }
                *(u32x4*)rowp = pack8(o0, o1);
            }
    }
};
struct EpiResid {
    static constexpr bool PERM = false, AFTER_DRAIN = true;
    const bf16_t* base; bf16_t* out; const float* gate; float gs;
    __device__ __forceinline__ void fused(f32x4 (&acc)[2][2][4][2], const Unit& u, int wr, int wc, int fr, int fq, PG8_LAS unsigned char* lds, int wid, int lane) const {
        asm volatile("" : "+v"(fr), "+v"(fq), "+v"(lane));
        PG8_LAS float* T = (PG8_LAS float*)lds;
        const int b = u.pm >> 5;
        const f32x4 gv = *(const f32x4*)(gate + b * 9216 + u.pn * BM + 4 * lane) * gs;
        h16x4 bsr[4][8];
#pragma unroll
        for (int ps = 0; ps < 4; ++ps)
#pragma unroll
            for (int q = 0; q < 8; ++q) {
                const int rl = wid * 8 + q, actual = (ps >> 1) * HALF + 64 * (rl >> 5) + 16 * (2 * (ps & 1) + ((rl >> 4) & 1)) + (rl & 15);
                bsr[ps][q] = *(const h16x4*)(base + (size_t)(u.pm * BM + actual) * 1024 + u.pn * BM + 4 * lane);
            }
#pragma unroll
        for (int ai = 0; ai < 2; ++ai)
#pragma unroll
            for (int mh = 0; mh < 2; ++mh) {
#pragma unroll
                for (int mp = 0; mp < 2; ++mp)
#pragma unroll
                    for (int bj = 0; bj < 2; ++bj)
#pragma unroll
                        for (int n = 0; n < 2; ++n)
                            *(PG8_LAS f32x4*)(T + (wr * 32 + mp * 16 + fr) * 272 + bj * HALF + wc * 32 + n * 16 + 4 * fq) = acc[ai][bj][2 * mh + mp][n];
                __syncthreads();
#pragma unroll
                for (int q = 0; q < 8; ++q) {
                    const int rl = wid * 8 + q, actual = ai * HALF + 64 * (rl >> 5) + 16 * (2 * mh + ((rl >> 4) & 1)) + (rl & 15);
                    const size_t off = (size_t)(u.pm * BM + actual) * 1024 + u.pn * BM + 4 * lane;
                    const f32x4 bs = __builtin_convertvector(bsr[2 * ai + mh][q], f32x4);
                    const f32x4 o = bs + gv * *(const PG8_LAS f32x4*)(T + rl * 272 + 4 * lane);
                    *(h16x4*)(out + off) = __builtin_convertvector(o, h16x4);
                }
                __syncthreads();
            }
    }
};
struct EpiGLU {
    static constexpr bool PERM = true, AFTER_DRAIN = false;
    bf16_t* xr; const float* gate;
    __device__ __forceinline__ void operator()(const f32x4 (&acc)[2][2][4][2], const Unit& u, int wr, int wc, int fr, int fq) const {
        asm volatile("" : "+v"(fr), "+v"(fq));
        const int b = u.pm >> 5, col = u.pn * HALF + wc * 32 + 8 * fq;
        const f32x4 g0 = *(const f32x4*)(gate + b * 9216 + col), g1 = *(const f32x4*)(gate + b * 9216 + col + 4);
#pragma unroll
        for (int ai = 0; ai < 2; ++ai)
#pragma unroll
            for (int m = 0; m < 4; ++m) {
                const size_t off = (size_t)(u.pm * BM + ai * HALF + wr * 64 + m * 16 + fr) * 1024 + col;
                const f32x4 r0 = __builtin_convertvector(*(const h16x4*)(xr + off), f32x4), r1 = __builtin_convertvector(*(const h16x4*)(xr + off + 4), f32x4);
                f32x4 o0, o1;
#pragma unroll
                for (int t = 0; t < 4; ++t) {
                    o0[t] = r0[t] + g0[t] * (acc[ai][0][m][0][t] * sigm_f(acc[ai][1][m][0][t]));
                    o1[t] = r1[t] + g1[t] * (acc[ai][0][m][1][t] * sigm_f(acc[ai][1][m][1][t]));
                }
                *(h16x4*)(xr + off) = __builtin_convertvector(o0, h16x4); *(h16x4*)(xr + off + 4) = __builtin_convertvector(o1, h16x4);
            }
    }
};
struct EpiRet3a {
    static constexpr bool PERM = true, AFTER_DRAIN = false;
    bf16_t* G; bf16_t* Q; bf16_t* K; bf16_t* KD; const float* rot;
    __device__ __forceinline__ void operator()(const f32x4 (&acc)[2][2][4][2], const Unit& u, int wr, int wc, int fr, int fq) const {
        asm volatile("" : "+v"(fr), "+v"(fq));
        const int row0 = u.pm * BM + wr * 64 + fr;
        if (u.pn < 8) {
            const int col0 = u.pn * BM + wc * 32 + 8 * fq;
#pragma unroll
            for (int ai = 0; ai < 2; ++ai)
#pragma unroll
                for (int m = 0; m < 4; ++m)
#pragma unroll
                    for (int bj = 0; bj < 2; ++bj) {
                        f32x4 o0, o1;
#pragma unroll
                        for (int i = 0; i < 4; ++i) { o0[i] = silu_f(acc[ai][bj][m][0][i]); o1[i] = silu_f(acc[ai][bj][m][1][i]); }
                        *(u32x4*)(G + (size_t)(row0 + ai * HALF + m * 16) * 2048 + col0 + bj * HALF) = pack8(o0, o1);
                    }
        } else {
            const int h = (u.pn - 8) & 3; const bool isk = u.pn >= 12; bf16_t* dst = isk ? K : Q; const float sc = isk ? 0.0625f : 1.0f;
            const int d0 = wc * 32 + 8 * fq;
#pragma unroll
            for (int ai = 0; ai < 2; ++ai)
#pragma unroll
                for (int m = 0; m < 4; ++m) {
                    const int row = row0 + ai * HALF + m * 16;
                    const f32x4* rp = (const f32x4*)(rot + ((size_t)row * 128 + d0) * 2);
                    f32x4 o1[2], o2[2];
#pragma unroll
                    for (int n = 0; n < 2; ++n) {
                        const f32x4 r0 = rp[2 * n], r1 = rp[2 * n + 1];
                        const f32x4 c = {r0[0], r0[2], r1[0], r1[2]}, s = {r0[1], r0[3], r1[1], r1[3]};
                        const f32x4 t1 = acc[ai][0][m][n], t2 = acc[ai][1][m][n];
                        o1[n] = (t1 * c - t2 * s) * sc; o2[n] = (t1 * s + t2 * c) * sc;
                    }
                    const size_t po = ((size_t)(row >> 4) * 32 + 8 * h + wc) * 512 + (fq * 16 + (row & 15)) * 8;
                    const float dec = isk ? __builtin_amdgcn_exp2f(log2f(1.0f - exp2f(-5.0f - (float)h)) * (float)(127 - (row & 127))) : 1.0f;
                    bf16_t* p = (isk ? KD : Q) + po;
                    *(u32x4*)p = pack8(o1[0] * dec, o1[1] * dec); *(u32x4*)(p + 4 * 512) = pack8(o2[0] * dec, o2[1] * dec);
                    asm volatile("" ::: "memory");
                }
        }
    }
};
struct EpiRet3b {
    static constexpr bool PERM = true, AFTER_DRAIN = false;
    bf16_t* VT;
    __device__ __forceinline__ void operator()(const f32x4 (&acc)[2][2][4][2], const Unit& u, int wr, int wc, int fr, int fq) const {
        asm volatile("" : "+v"(fr), "+v"(fq));
        const int f0 = u.pm * BM + wr * 64 + fr, t0 = u.pn * BM + wc * 32 + 8 * fq;
#pragma unroll
        for (int ai = 0; ai < 2; ++ai)
#pragma unroll
            for (int m = 0; m < 4; ++m)
#pragma unroll
                for (int bj = 0; bj < 2; ++bj)
                    *(u32x4*)(VT + ((size_t)((f0 + ai * HALF + m * 16) >> 4) * 256 + ((t0 + bj * HALF) >> 5)) * 512 + (fq * 16 + fr) * 8) = pack8(acc[ai][bj][m][0], acc[ai][bj][m][1]);
    }
};
struct S5Order {
    int G, c;
    __host__ __device__ bool next(int i, Unit& u) const { const int L = i * G + c; if (L >= 256) return false; u.pm = L; u.pn = L >> 2; return true; }
    __device__ __forceinline__ void a_ready(const Unit&) const {}
    __device__ __forceinline__ void done(const Unit&) const {}
};
struct EpiS5A {
    static constexpr bool PERM = true, AFTER_DRAIN = false;
    float* Sloc;
    __device__ __forceinline__ void operator()(const f32x4 (&acc)[2][2][4][2], const Unit& u, int wr, int wc, int fr, int fq) const {
        asm volatile("" : "+v"(fr), "+v"(fq));
        const int g = u.pn, c0 = (u.pm & 3) * BM + wr * 64 + fr, n0 = wc * 32 + 8 * fq;
#pragma unroll
        for (int ai = 0; ai < 2; ++ai)
#pragma unroll
            for (int m = 0; m < 4; ++m) {
                float* p = Sloc + ((size_t)(c0 + ai * HALF + m * 16) * 64 + g) * 128 + n0;
                *(f32x4*)p = acc[ai][0][m][0]; *(f32x4*)(p + 4) = acc[ai][0][m][1];
            }
    }
};
struct EpiS5C {
    static constexpr bool PERM = true, AFTER_DRAIN = false;
    const bf16_t* XN; const float* dsk; bf16_t* YG;
    __device__ __forceinline__ void operator()(const f32x4 (&acc)[2][2][4][2], const Unit& u, int wr, int wc, int fr, int fq) const {
        asm volatile("" : "+v"(fr), "+v"(fq));
        const int g = u.pn, c0 = (u.pm & 3) * BM + wr * 64 + fr, ch = 16 * g + 8 * (fq & 1);
        const f32x4 d0 = *(const f32x4*)(dsk + ch), d1 = *(const f32x4*)(dsk + ch + 4);
#pragma unroll
        for (int ai = 0; ai < 2; ++ai)
#pragma unroll
            for (int m = 0; m < 4; ++m)
#pragma unroll
                for (int bj = 0; bj < 2; ++bj) {
                    const int i = 8 * bj + 2 * wc + (fq >> 1);
                    const size_t idx = (size_t)(16 * (c0 + ai * HALF + m * 16) + i) * 1024 + ch;
                    const u32x4 uv = *(const u32x4*)(XN + idx);
                    f32x4 y0 = acc[ai][bj][m][0], y1 = acc[ai][bj][m][1];
#pragma unroll
                    for (int t = 0; t < 2; ++t) {
                        y0[2 * t] += d0[2 * t] * __builtin_bit_cast(float, uv[t] << 16); y0[2 * t + 1] += d0[2 * t + 1] * __builtin_bit_cast(float, uv[t] & 0xffff0000u);
                        y1[2 * t] += d1[2 * t] * __builtin_bit_cast(float, uv[2 + t] << 16); y1[2 * t + 1] += d1[2 * t + 1] * __builtin_bit_cast(float, uv[2 + t] & 0xffff0000u);
                    }
#pragma unroll
                    for (int t = 0; t < 4; ++t) {
                        const float a = y0[t], b = y1[t];
                        y0[t] = a * __builtin_amdgcn_rcpf(1.f + __expf(-1.5957691216f * (a + 0.044715f * a * a * a)));
                        y1[t] = b * __builtin_amdgcn_rcpf(1.f + __expf(-1.5957691216f * (b + 0.044715f * b * b * b)));
                    }
                    *(u32x4*)(YG + idx) = pack8(y0, y1);
                }
    }
};
template <class Epi, class Sched, bool ALIGN_EPI = false, bool SP2 = false>
__device__ __forceinline__ void gemm_phase(PG8_LAS unsigned char* lds, const Gemm g, const Sched& S, const Epi& E) {
    int tid_ = threadIdx.x; asm volatile("" : "+v"(tid_));
    const int tid = tid_, wid = __builtin_amdgcn_readfirstlane(tid >> 6), lane = tid & 63, wr = wid >> 2, wc = wid & 3, fr = lane & 15, fq = lane >> 4;
    const int K = g.K, nt = K / BK;
    unsigned voffA[2], voffB[2];
#pragma unroll
    for (int i = 0; i < 2; ++i) { int R, C; stage_rc(tid * 16 + i * 8192, R, C); const int Rb = Epi::PERM ? ((R & ~31) + perm32(R & 31)) : R;
        voffA[i] = (unsigned)(R * K + C) * 2u; voffB[i] = (unsigned)(Rb * K + C) * 2u; }
    const size_t kstep = (size_t)(BK * 2);
    const size_t hstep = (size_t)HALF * K * 2;
    const size_t tstep = 2 * hstep;
    const unsigned ldsw = (unsigned)wid * 1024u;
    const int aoff = lds_byte(wr * 64 + fr, fq * 8), boff = lds_byte(wc * 32 + fr, fq * 8);
#define PG8_SA(b, h) (((b) * 2 + (h)) * HTB)
#define PG8_SB(b, h) ((4 + (b) * 2 + (h)) * HTB)
#define PG8_STAGE(bufoff, gbase, voff) do { _Pragma("unroll") for (int _i = 0; _i < 2; ++_i) \
        __builtin_amdgcn_global_load_lds((const unsigned*)((const char*)(gbase) + (voff)[_i]), (PG8_LAS unsigned*)(lds + (bufoff) + ldsw + _i * 8192), 16, 0, 0); } while (0)
#define PG8_LDA(dst, b, h) do { _Pragma("unroll") for (int m = 0; m < 4; ++m) _Pragma("unroll") for (int k = 0; k < 2; ++k) dst[m][k] = *(const PG8_LAS bf16x8*)(lds + PG8_SA(b, h) + aoff + m * 2048 + k * 1024); } while (0)
#define PG8_LDB(dst, b, h) do { _Pragma("unroll") for (int n = 0; n < 2; ++n) _Pragma("unroll") for (int k = 0; k < 2; ++k) dst[n][k] = *(const PG8_LAS bf16x8*)(lds + PG8_SB(b, h) + boff + n * 2048 + k * 1024); } while (0)
#define PG8_MMA(ai, bj, At, Bt) do { __builtin_amdgcn_s_setprio(1); _Pragma("unroll") for (int m = 0; m < 4; ++m) _Pragma("unroll") for (int n = 0; n < 2; ++n) _Pragma("unroll") for (int k = 0; k < 2; ++k) \
        acc[ai][bj][m][n] = __builtin_amdgcn_mfma_f32_16x16x32_bf16(Bt[n][k], At[m][k], acc[ai][bj][m][n], 0, 0, 0); __builtin_amdgcn_s_setprio(0); } while (0)
#define PG8_WAIT_V(n) asm volatile("s_waitcnt vmcnt(" #n ")" ::: "memory")
#define PG8_WAIT_L(n) asm volatile("s_waitcnt lgkmcnt(" #n ")" ::: "memory")
#define PG8_BAR __builtin_amdgcn_s_barrier()
#define PG8_SCHED __builtin_amdgcn_sched_barrier(0)
    Unit cur, nxt; int ui = 0;
    if (!S.next(0, cur)) return;
    f32x4 acc[2][2][4][2];
#pragma unroll
    for (int a = 0; a < 2; ++a)
#pragma unroll
        for (int b = 0; b < 2; ++b)
#pragma unroll
            for (int m = 0; m < 4; ++m)
#pragma unroll
                for (int n = 0; n < 2; ++n) acc[a][b][m][n] = (f32x4){0.f, 0.f, 0.f, 0.f};
    bf16x8 At[4][2], B0[2][2], B1[2][2];
    const char* cA = (const char*)g.A + (size_t)cur.pm * tstep; const char* cB = (const char*)g.Bt + (size_t)cur.pn * tstep;
    S.a_ready(cur);
    if constexpr (SP2) {
        PG8_STAGE(PG8_SB(0, 0), cB, voffB); PG8_STAGE(PG8_SB(0, 1), cB + hstep, voffB); PG8_STAGE(PG8_SA(0, 0), cA, voffA); PG8_STAGE(PG8_SA(0, 1), cA + hstep, voffA);
        if (wr == 1) PG8_BAR;
        PG8_WAIT_V(2); PG8_BAR;
        PG8_STAGE(PG8_SB(1, 0), cB + kstep, voffB); PG8_STAGE(PG8_SA(1, 0), cA + kstep, voffA); PG8_STAGE(PG8_SB(1, 1), cB + hstep + kstep, voffB);
        PG8_WAIT_V(6); PG8_BAR;
    } else {
        PG8_STAGE(PG8_SB(0, 0), cB, voffB); PG8_STAGE(PG8_SA(0, 0), cA, voffA); PG8_STAGE(PG8_SB(0, 1), cB + hstep, voffB); PG8_STAGE(PG8_SA(0, 1), cA + hstep, voffA);
        if (wr == 1) PG8_BAR;
        PG8_WAIT_V(4); PG8_BAR;
        PG8_STAGE(PG8_SB(1, 0), cB + kstep, voffB); PG8_STAGE(PG8_SA(1, 0), cA + kstep, voffA); PG8_STAGE(PG8_SB(1, 1), cB + hstep + kstep, voffB);
        PG8_WAIT_V(6); PG8_BAR;
    }
    for (;;) {
        const bool has_next = S.next(ui + 1, nxt);
        const char* nA = has_next ? (const char*)g.A + (size_t)nxt.pm * tstep : cA; const char* nB = has_next ? (const char*)g.Bt + (size_t)nxt.pn * tstep : cB;
        for (int t = 0; t < nt; t += 2) {
            const bool last = (t == nt - 2);
            const char* a1 = cA + (size_t)(t + 1) * kstep;
            const char* a2 = last ? nA : cA + (size_t)(t + 2) * kstep; const char* b2 = last ? nB : cB + (size_t)(t + 2) * kstep;
            const char* a3 = a2 + kstep; const char* b3 = b2 + kstep;
            if (last && has_next) S.a_ready(nxt);
            if constexpr (SP2) {
            PG8_LDB(B0, 0, 0); PG8_LDB(B1, 0, 1); PG8_SCHED; PG8_LDA(At, 0, 0); PG8_STAGE(PG8_SA(1, 1), a1 + hstep, voffA);
            PG8_WAIT_V(8); PG8_WAIT_L(0); PG8_BAR; PG8_MMA(0, 0, At, B0); PG8_MMA(0, 1, At, B1); PG8_BAR; PG8_SCHED;
            PG8_LDA(At, 0, 1); PG8_STAGE(PG8_SB(0, 0), b2, voffB); PG8_STAGE(PG8_SB(0, 1), b2 + hstep, voffB); PG8_STAGE(PG8_SA(0, 0), a2, voffA);
            PG8_WAIT_V(8); PG8_WAIT_L(0); PG8_BAR; PG8_MMA(1, 0, At, B0); PG8_MMA(1, 1, At, B1); PG8_BAR; PG8_SCHED;
            PG8_LDB(B0, 1, 0); PG8_LDB(B1, 1, 1); PG8_SCHED; PG8_LDA(At, 1, 0); PG8_STAGE(PG8_SA(0, 1), a2 + hstep, voffA);
            PG8_WAIT_V(8); PG8_WAIT_L(0); PG8_BAR; PG8_MMA(0, 0, At, B0); PG8_MMA(0, 1, At, B1); PG8_BAR; PG8_SCHED;
            PG8_LDA(At, 1, 1); PG8_STAGE(PG8_SB(1, 0), b3, voffB); PG8_STAGE(PG8_SB(1, 1), b3 + hstep, voffB); PG8_STAGE(PG8_SA(1, 0), a3, voffA);
            PG8_WAIT_V(8); PG8_WAIT_L(0); PG8_BAR; PG8_MMA(1, 0, At, B0); PG8_MMA(1, 1, At, B1); PG8_BAR; PG8_SCHED;
            } else {
            PG8_LDB(B0, 0, 0); PG8_SCHED; PG8_LDA(At, 0, 0); PG8_STAGE(PG8_SA(1, 1), a1 + hstep, voffA);
            PG8_WAIT_L(8); PG8_BAR; PG8_WAIT_L(0); PG8_MMA(0, 0, At, B0); PG8_BAR; PG8_SCHED;
            PG8_LDB(B1, 0, 1); PG8_STAGE(PG8_SB(0, 0), b2, voffB);
            PG8_BAR; PG8_WAIT_L(0); PG8_MMA(0, 1, At, B1); PG8_BAR;
            PG8_LDA(At, 0, 1); PG8_STAGE(PG8_SA(0, 0), a2, voffA);
            PG8_BAR; PG8_WAIT_L(0); PG8_MMA(1, 0, At, B0); PG8_BAR; PG8_SCHED;
            PG8_STAGE(PG8_SB(0, 1), b2 + hstep, voffB);
            PG8_WAIT_V(6); PG8_BAR; PG8_MMA(1, 1, At, B1); PG8_BAR;
            PG8_LDB(B0, 1, 0); PG8_SCHED; PG8_LDA(At, 1, 0); PG8_STAGE(PG8_SA(0, 1), a2 + hstep, voffA);
            PG8_WAIT_L(8); PG8_BAR; PG8_WAIT_L(0); PG8_MMA(0, 0, At, B0); PG8_BAR; PG8_SCHED;
            PG8_LDB(B1, 1, 1); PG8_STAGE(PG8_SB(1, 0), b3, voffB);
            PG8_BAR; PG8_WAIT_L(0); PG8_MMA(0, 1, At, B1); PG8_BAR;
            PG8_LDA(At, 1, 1); PG8_STAGE(PG8_SA(1, 0), a3, voffA);
            PG8_BAR; PG8_WAIT_L(0); PG8_MMA(1, 0, At, B0); PG8_BAR; PG8_SCHED;
            PG8_STAGE(PG8_SB(1, 1), b3 + hstep, voffB);
            PG8_WAIT_V(6); PG8_BAR; PG8_MMA(1, 1, At, B1); PG8_BAR;
            }
        }
        if constexpr (ALIGN_EPI) { if (wr == 0) PG8_BAR; }
        if constexpr (!Epi::AFTER_DRAIN) { E(acc, cur, wr, wc, (int)(threadIdx.x & 15u), (int)((threadIdx.x >> 4) & 3u)); S.done(cur); }
        if (!has_next) break;
#pragma unroll
        for (int a = 0; a < 2; ++a)
#pragma unroll
            for (int b = 0; b < 2; ++b)
#pragma unroll
                for (int m = 0; m < 4; ++m)
#pragma unroll
                    for (int n = 0; n < 2; ++n) acc[a][b][m][n] = (f32x4){0.f, 0.f, 0.f, 0.f};
        cur = nxt; cA = nA; cB = nB; ++ui;
        if constexpr (ALIGN_EPI) { if (wr == 1) PG8_BAR; }
    }
    PG8_WAIT_V(0);
    if constexpr (!ALIGN_EPI) { if (wr == 0) PG8_BAR; }
    PG8_BAR;
    if constexpr (Epi::AFTER_DRAIN) { E.fused(acc, cur, wr, wc, (int)(threadIdx.x & 15u), (int)((threadIdx.x >> 4) & 3u), lds, wid, (int)(threadIdx.x & 63u)); S.done(cur); }
#undef PG8_SA
#undef PG8_SB
#undef PG8_STAGE
#undef PG8_LDA
#undef PG8_LDB
#undef PG8_MMA
#undef PG8_WAIT_V
#undef PG8_WAIT_L
#undef PG8_BAR
#undef PG8_SCHED
}
}

#define LAS __attribute__((address_space(3)))
typedef unsigned short bf16;
typedef float f32x4 __attribute__((ext_vector_type(4)));
typedef float f32x2 __attribute__((ext_vector_type(2)));
typedef short bf16x8 __attribute__((ext_vector_type(8)));
typedef unsigned u32x2 __attribute__((ext_vector_type(2)));
typedef unsigned u32x4 __attribute__((ext_vector_type(4)));
typedef _Float16 h16x4 __attribute__((ext_vector_type(4)));

constexpr int NWAVES = 8, NTHR = 512;
constexpr int Mtok = 16384, Dm = 1024, Lseq = 8192, FF = 2816;
constexpr size_t MiB = 1u << 20;
constexpr size_t WS_MODS = 0;
constexpr size_t WS_APW = 256 * 1024;
constexpr size_t WS_EPW = 1024 * 1024;
constexpr size_t WS_BAR = 1792 * 1024;
constexpr size_t WS_WB = 2 * MiB;
constexpr size_t WS_WB2 = 14 * MiB;
constexpr size_t WS_XN = 22 * MiB;
constexpr size_t WS_ROT = 54 * MiB;
constexpr size_t WS_BIG = 70 * MiB;
constexpr size_t WS_H = WS_BIG;
constexpr size_t WS_G = WS_BIG;
constexpr size_t WS_Q = WS_BIG + 64 * MiB;
constexpr size_t WS_K = WS_BIG + 80 * MiB;
constexpr size_t WS_KT = WS_BIG + 96 * MiB;
constexpr size_t WS_VT = WS_BIG + 112 * MiB;
constexpr size_t WS_KV = WS_BIG + 144 * MiB;
constexpr size_t WS_XH = WS_BIG;
constexpr size_t WS_SLOC = WS_BIG + 48 * MiB;
constexpr size_t WS_YG = WS_BIG + 80 * MiB;
constexpr size_t WS_TC = WS_BIG + 112 * MiB;
constexpr size_t WS_SP = WS_BIG + 124 * MiB;
constexpr size_t WS_END = WS_BIG + 208 * MiB;

constexpr int LDS_BYTES = 135168;

__device__ __forceinline__ unsigned f2bf(float f) { unsigned u = __builtin_bit_cast(unsigned, f); return (u + 0x7fffu + ((u >> 16) & 1u)) >> 16; }
__device__ __forceinline__ unsigned pk2(float lo, float hi) { return f2bf(lo) | (f2bf(hi) << 16); }
__device__ __forceinline__ float bf2f(unsigned short h) { return __builtin_bit_cast(float, (unsigned)h << 16); }
__device__ __forceinline__ float shx(float v, int o, int lane) { return __builtin_bit_cast(float, __builtin_amdgcn_ds_bpermute((lane ^ o) << 2, __builtin_bit_cast(int, v))); }
__device__ __forceinline__ float wave_sum(float v, int lane) {
#pragma unroll
    for (int o = 1; o < 64; o <<= 1) v += shx(v, o, lane);
    return v;
}

enum { K_PRO = 0, K_ROW, K_FFN_IN, K_FFN_OUT, K_G3, K_R1, K_R2, K_R3, K_RETOUT, K_S5A, K_S5B, K_S5C, K_GLU, K_FINAL };
constexpr int MAXPH = 64;
struct Params {
    const float* x; const float* c; const int* pos; const float* ada_w; const float* ada_b; const float* norm_g;
    const float* ffn_w_in; const float* ffn_w_out; const float* ret_w_in; const float* ret_w_out;
    const float* a_re; const float* a_im; const float* b_re; const float* b_im; const float* c_re; const float* c_im;
    const float* s5_d; const float* log_dt; const float* w_glu; const float* final_g;
    float* out; unsigned char* ws;
    int nph; int pad;
    unsigned char ph[MAXPH][4];
};

typedef const __attribute__((address_space(4))) Params* KP;

__device__ __forceinline__ int map_row(int mode, int hv, int n) {
    if (mode == 1) { const int up = n >= hv ? 1 : 0, j = n - up * hv; return 256 * (j >> 7) + 128 * up + (j & 127); }
    if (mode == 2) { return n < 4096 ? n + 2048 : n - 4096; }
    return n;
}
__device__ __forceinline__ void conv_item(const float* W, int K, int N, bf16* WT, int mode, int hv, LAS float* scr, int item, int lane) {
    const int nblk = N / 32, kb = item / nblk, nb = item % nblk, k0 = 64 * kb, n0 = 32 * nb;
    float tv[32];
#pragma unroll
    for (int i = 0; i < 32; ++i) tv[i] = __builtin_nontemporal_load(&W[(size_t)(k0 + 2 * i + (lane >> 5)) * N + n0 + (lane & 31)]);
#pragma unroll
    for (int i = 0; i < 32; ++i) scr[(2 * i + (lane >> 5)) * 33 + (lane & 31)] = tv[i];
    asm volatile("s_waitcnt lgkmcnt(0)" ::: "memory");
    const int c = lane & 7;
#pragma unroll
    for (int j = 0; j < 4; ++j) { const int n = (lane >> 3) + 8 * j; const LAS float* s = scr + (8 * c) * 33 + n;
        u32x4 o; o.x = pk2(s[0 * 33], s[1 * 33]); o.y = pk2(s[2 * 33], s[3 * 33]); o.z = pk2(s[4 * 33], s[5 * 33]); o.w = pk2(s[6 * 33], s[7 * 33]);
        *(u32x4*)(WT + (size_t)map_row(mode, hv, n0 + n) * K + k0 + 8 * c) = o; }
    asm volatile("s_waitcnt lgkmcnt(0)" ::: "memory");
}
__device__ __forceinline__ void conv_job(const float* W, int K, int N, bf16* WT, int mode, int hv, LAS float* scr, int gw, int ngw, int lane) {
    const int nitems = (K / 64) * (N / 32);
    for (int it = gw; it < nitems; it += ngw) conv_item(W, K, N, WT, mode, hv, scr, it, lane);
}

__device__ __forceinline__ void row_pass(const void* xin, int in_f32, const float* gvec, const float* sh, const float* sc, bf16* XN, bf16* XH, bf16* XC, int gw, int ngw, int lane) {
    for (int m0 = gw; m0 < Mtok; m0 += 4 * ngw) {
        f32x4 v[4][4]; float s[4];
#pragma unroll
        for (int r = 0; r < 4; ++r) {
            const int m = m0 + r * ngw; const size_t ro = (size_t)(m < Mtok ? m : m0) * Dm;
            if (in_f32) {
#pragma unroll
                for (int j = 0; j < 4; ++j) v[r][j] = __builtin_nontemporal_load((const f32x4*)((const float*)xin + ro) + lane + 64 * j);
            } else {
#pragma unroll
                for (int j = 0; j < 4; ++j) v[r][j] = __builtin_convertvector(*((const h16x4*)((const bf16*)xin + ro) + lane + 64 * j), f32x4);
            }
        }
#pragma unroll
        for (int r = 0; r < 4; ++r) {
            float a = 0.f;
#pragma unroll
            for (int j = 0; j < 4; ++j) a += (v[r][j][0] * v[r][j][0] + v[r][j][1] * v[r][j][1]) + (v[r][j][2] * v[r][j][2] + v[r][j][3] * v[r][j][3]);
            s[r] = 1.0f / sqrtf(wave_sum(a, lane) * (1.0f / Dm) + 1e-6f);
        }
#pragma unroll
        for (int j = 0; j < 4; ++j) {
            const int col = 4 * lane + 256 * j;
            const f32x4 g = *(const f32x4*)(gvec + col);
#pragma unroll
            for (int r = 0; r < 4; ++r) {
                const int m = m0 + r * ngw;
                if (m < Mtok) {
                    const int b = m >> 13;
                    const f32x4 s1 = *(const f32x4*)(sc + b * 9216 + col), s0 = *(const f32x4*)(sh + b * 9216 + col);
                    const f32x4 y = (v[r][j] * s[r] * g) * (s1 + 1.0f) + s0;
                    const unsigned long long pv = (unsigned long long)pk2(y[0], y[1]) | ((unsigned long long)pk2(y[2], y[3]) << 32);
                    *((unsigned long long*)(XN + (size_t)m * Dm) + lane + 64 * j) = pv;
                    if (XC) *((h16x4*)(XC + (size_t)m * Dm) + lane + 64 * j) = __builtin_convertvector(v[r][j], h16x4);
                    if (XH) *(unsigned long long*)(XH + ((size_t)(col >> 4) * 1024 + (m >> 4)) * 384 + 16 * (m & 15) + (col & 15)) = pv;
                }
            }
        }
    }
}
__device__ __forceinline__ void final_norm(const bf16* xr_, float* outp, const float* gvec, int gw, int ngw, int lane) {
    for (int m0 = gw; m0 < Mtok; m0 += 4 * ngw) {
        f32x4 v[4][4]; float s[4];
#pragma unroll
        for (int r = 0; r < 4; ++r) {
            const int m = m0 + r * ngw; const size_t ro = (size_t)(m < Mtok ? m : m0) * Dm;
#pragma unroll
            for (int j = 0; j < 4; ++j) v[r][j] = __builtin_convertvector(*((const h16x4*)(xr_ + ro) + lane + 64 * j), f32x4);
        }
#pragma unroll
        for (int r = 0; r < 4; ++r) {
            float a = 0.f;
#pragma unroll
            for (int j = 0; j < 4; ++j) a += (v[r][j][0] * v[r][j][0] + v[r][j][1] * v[r][j][1]) + (v[r][j][2] * v[r][j][2] + v[r][j][3] * v[r][j][3]);
            s[r] = 1.0f / sqrtf(wave_sum(a, lane) * (1.0f / Dm) + 1e-6f);
        }
#pragma unroll
        for (int j = 0; j < 4; ++j) {
            const f32x4 g = *(const f32x4*)(gvec + 4 * lane + 256 * j);
#pragma unroll
            for (int r = 0; r < 4; ++r) { const int m = m0 + r * ngw; if (m < Mtok) __builtin_nontemporal_store(v[r][j] * s[r] * g, (f32x4*)(outp + (size_t)m * Dm) + lane + 64 * j); }
        }
    }
}

__device__ __forceinline__ void prologue(KP P, LAS unsigned char* lds, int bid, int G, int tid, int w, int lane) {
    float* mods = (float*)(P->ws + WS_MODS);
    LAS float* red = (LAS float*)lds;
    for (int it = bid; it < 72; it += G) {
        const int l = it / 36, cb = it % 36;
        f32x4 a0 = {0.f, 0.f, 0.f, 0.f}, a1 = {0.f, 0.f, 0.f, 0.f};
        const float* wp = P->ada_w + ((size_t)l * 1024 + 128 * w) * 9216 + 256 * cb + 4 * lane;
#pragma unroll 16
        for (int kk = 0; kk < 128; ++kk) {
            const f32x4 wv = __builtin_nontemporal_load((const f32x4*)(wp + (size_t)kk * 9216));
            const float c0 = P->c[128 * w + kk], c1 = P->c[1024 + 128 * w + kk];
            const float s0 = c0 / (1.f + __expf(-c0)), s1 = c1 / (1.f + __expf(-c1));
            a0 += wv * s0; a1 += wv * s1;
        }
#pragma unroll
        for (int i = 0; i < 4; ++i) { red[(w * 2 + 0) * 256 + 4 * lane + i] = a0[i]; red[(w * 2 + 1) * 256 + 4 * lane + i] = a1[i]; }
        __syncthreads();
        { const int b = tid >> 8, col = tid & 255; float s = 0.f;
#pragma unroll
          for (int ww = 0; ww < 8; ++ww) s += red[(ww * 2 + b) * 256 + col];
          mods[(size_t)(l * 2 + b) * 9216 + 256 * cb + col] = s + P->ada_b[l * 9216 + 256 * cb + col]; }
        __syncthreads();
    }
    if (G > 144 && bid < 72) return;
    const int gt = (G > 144 ? bid - 72 : bid) * NTHR + tid, ngt = (G > 144 ? G - 72 : G) * NTHR;
    float* rot = (float*)(P->ws + WS_ROT);
    for (int e = gt; e < Mtok * 128; e += ngt) {
        const int m = e >> 7, d = e & 127;
        double invf = 1.0, bs = 0.9305720409296990;
#pragma unroll
        for (int q = 0; q < 7; ++q) { if ((d >> q) & 1) invf *= bs; bs *= bs; }
        const double a = (double)P->pos[m] * invf;
        const double kq = __builtin_rint(a * 0.15915494309189535);
        const float fr_ = (float)__builtin_fma(a, 0.15915494309189535, -kq);
        *(f32x2*)(rot + (size_t)e * 2) = (f32x2){__builtin_amdgcn_cosf(fr_), __builtin_amdgcn_sinf(fr_)};
    }
    f32x2* apw = (f32x2*)(P->ws + WS_APW); f32x2* epw = (f32x2*)(P->ws + WS_EPW);
    for (int e = gt; e < 64 * 64 * 17; e += ngt) {
        const int t = e % 17, gp = e / 17, g = gp >> 6;
        const float dt = __expf(P->log_dt[g]);
        const float are = P->a_re[gp], aim = P->a_im[gp];
        const float mg = __expf((float)t * dt * are);
        const double an = (double)t * (double)dt * (double)aim * 0.15915494309189535;
        const float fa = (float)(an - __builtin_rint(an));
        const float pr = mg * __builtin_amdgcn_cosf(fa), pi = mg * __builtin_amdgcn_sinf(fa);
        apw[e] = (f32x2){pr, pi};
        if (t < 16) {
            const float xx = dt * are;
            const float em1 = xx * (1.f + xx * (0.5f + xx * (0.16666667f + xx * (0.041666668f + xx * 0.0083333338f))));
            const double a1 = (double)dt * (double)aim * 0.15915494309189535;
            const float f1 = (float)(a1 - __builtin_rint(a1)); const double a2 = 0.5 * a1; const float f2 = (float)(a2 - __builtin_rint(a2));
            const float c1 = __builtin_amdgcn_cosf(f1), s1 = __builtin_amdgcn_sinf(f1), sh = __builtin_amdgcn_sinf(f2);
            const float br = em1 * c1 - 2.f * sh * sh, bi = (1.f + em1) * s1;
            const float den = are * are + aim * aim;
            const float wr = (br * are + bi * aim) / den, wi = (bi * are - br * aim) / den;
            epw[gp * 16 + t] = (f32x2){pr * wr - pi * wi, pr * wi + pi * wr};
        }
    }
}

__device__ __forceinline__ void s5_build(KP P, int gt, int ngt) {
    const f32x2* apw = (const f32x2*)(P->ws + WS_APW); const f32x2* epw = (const f32x2*)(P->ws + WS_EPW);
    bf16* TC = (bf16*)(P->ws + WS_TC); bf16* SP = (bf16*)(P->ws + WS_SP);
    for (int e = gt; e < 64 * 16 * 16 * 16; e += ngt) {
        const int kp = e & 15, k = (e >> 4) & 15, d = (e >> 8) & 15, g = e >> 12;
        float acc = 0.f;
        for (int p = 0; p < 64; ++p) {
            const f32x2 E = epw[(g * 64 + p) * 16 + d];
            const float br = P->b_re[((size_t)g * 64 + p) * 16 + kp], bi = P->b_im[((size_t)g * 64 + p) * 16 + kp];
            const float zr = E.x * br - E.y * bi, zi = E.x * bi + E.y * br;
            const float cr = P->c_re[((size_t)g * 16 + k) * 64 + p], ci = P->c_im[((size_t)g * 16 + k) * 64 + p];
            acc += cr * zr - ci * zi;
        }
        const bf16 v = (bf16)f2bf(acc);
        bf16* tg = TC + (size_t)g * 256 * 384;
        for (int j = 0; j + d < 16; ++j) { const int i = j + d; tg[(16 * i + k) * 384 + 16 * j + kp] = v; }
        if (d >= 1) for (int i = 0; i + d < 16; ++i) { const int j = i + d; tg[(16 * i + k) * 384 + 16 * j + kp] = 0; }
    }
    for (int e = gt; e < 64 * 64 * 16 * 16; e += ngt) {
        const int kp = e & 15, j = (e >> 4) & 15, p = (e >> 8) & 63, g = e >> 14;
        const f32x2 E = epw[(g * 64 + p) * 16 + (15 - j)];
        const float br = P->b_re[((size_t)g * 64 + p) * 16 + kp], bi = P->b_im[((size_t)g * 64 + p) * 16 + kp];
        bf16* sg = SP + (size_t)g * 256 * 384;
        sg[(2 * p) * 384 + 16 * j + kp] = (bf16)f2bf(E.x * br - E.y * bi);
        sg[(2 * p + 1) * 384 + 16 * j + kp] = (bf16)f2bf(E.x * bi + E.y * br);
    }
    for (int e = gt; e < 64 * 256 * 192; e += ngt) {
        const int g = e / (256 * 192), r = (e / 192) & 255, cp = e % 192;
        unsigned* sg = (unsigned*)(SP + (size_t)g * 256 * 384 + (size_t)r * 384);
        if (r >= 128 || cp >= 128) sg[cp] = 0u;
    }
    for (int e = gt; e < 64 * 16 * 16 * 64; e += ngt) {
        const int p = e & 63, k = (e >> 6) & 15, i = (e >> 10) & 15, g = e >> 14;
        const f32x2 A = apw[(g * 64 + p) * 17 + i + 1];
        const float cr = P->c_re[((size_t)g * 16 + k) * 64 + p], ci = P->c_im[((size_t)g * 16 + k) * 64 + p];
        const float wr = cr * A.x - ci * A.y, wi = cr * A.y + ci * A.x;
        *(unsigned*)(TC + (size_t)g * 256 * 384 + (16 * i + k) * 384 + 256 + 2 * p) = pk2(wr, -wi);
    }
}

#define MFMA16(a, b, c) __builtin_amdgcn_mfma_f32_16x16x32_bf16((a), (b), (c), 0, 0, 0)

__device__ __forceinline__ void s5b_phase(const float* Sloc, const f32x2* apw, bf16* XH, LAS unsigned char* lds, int bid, int G, int w, int lane) {
    LAS f32x2* E = (LAS f32x2*)lds;
    for (int u = bid; u < 128; u += G) {
        const int b = u >> 6, g = u & 63, p = lane;
        const f32x2 A16 = apw[(g * 64 + p) * 17 + 16];
        const float* sp = Sloc + ((size_t)(b * 512 + 64 * w) * 64 + g) * 128 + 2 * p;
        bf16* hp = XH + ((size_t)g * 1024 + b * 512 + 64 * w) * 384 + 256 + 2 * p;
        float er = 0.f, ei = 0.f;
#pragma unroll 1
        for (int hf = 0; hf < 2; ++hf) {
            f32x2 sv[32];
#pragma unroll
            for (int q = 0; q < 32; ++q) sv[q] = *(const f32x2*)(sp + (size_t)(32 * hf + q) * 8192);
#pragma unroll
            for (int q = 0; q < 32; ++q) { const float nr = A16.x * er - A16.y * ei + sv[q].x, ni = A16.x * ei + A16.y * er + sv[q].y; er = nr; ei = ni; }
        }
        E[w * 64 + p] = (f32x2){er, ei};
        float pr = A16.x, pi = A16.y;
#pragma unroll
        for (int q = 0; q < 6; ++q) { const float nr = pr * pr - pi * pi, ni = 2.f * pr * pi; pr = nr; pi = ni; }
        __syncthreads();
        float hr = 0.f, hi = 0.f;
        for (int k = 0; k < w; ++k) { const f32x2 e = E[k * 64 + p]; const float nr = pr * hr - pi * hi + e.x, ni = pr * hi + pi * hr + e.y; hr = nr; hi = ni; }
#pragma unroll 1
        for (int hf = 0; hf < 2; ++hf) {
            f32x2 sv[32];
#pragma unroll
            for (int q = 0; q < 32; ++q) sv[q] = *(const f32x2*)(sp + (size_t)(32 * hf + q) * 8192);
#pragma unroll
            for (int q = 0; q < 32; ++q) {
                *(unsigned*)(hp + (size_t)(32 * hf + q) * 384) = pk2(hr, hi);
                const float nr = A16.x * hr - A16.y * hi + sv[q].x, ni = A16.x * hi + A16.y * hr + sv[q].y; hr = nr; hi = ni;
            }
        }
        __syncthreads();
    }
}
__device__ __forceinline__ void r1_phase(const bf16* KD, const bf16* VT, bf16* KV, LAS unsigned char* lds, int bid, int G, int w, int lane_) {
    for (int u = bid; u < 256; u += G) {
        int lane = lane_; asm volatile("" : "+v"(lane));
        const int fr = lane & 15, fq = lane >> 4;
        const int h = u >> 6, n = u & 63;
        const char* kdu = (const char*)(KD + ((size_t)(8 * n) * 32 + 8 * h) * 512);
        const char* vtu = (const char*)(VT + ((size_t)(32 * h) * 256 + 4 * n) * 512);
#pragma unroll
        for (int q = 0; q < 8; ++q)
            __builtin_amdgcn_global_load_lds((const unsigned*)(kdu + (size_t)(w * 32 + q) * 1024 + lane * 16), (LAS unsigned*)(lds + (8 * w + q) * 1024), 16, 0, 0);
#define R1_DMA(p, bufoff) do { _Pragma("unroll") for (int q_ = 0; q_ < 4; ++q_) \
        __builtin_amdgcn_global_load_lds((const unsigned*)(vtu + (size_t)(8 * (p) + w) * 262144 + q_ * 1024 + lane * 16), (LAS unsigned*)(lds + (bufoff) + (4 * w + q_) * 1024), 16, 0, 0); } while (0)
        R1_DMA(0, 65536);
        asm volatile("s_waitcnt vmcnt(0)" ::: "memory");
        __syncthreads();
        bf16x8 af[2][4];
#pragma unroll
        for (int rbl = 0; rbl < 2; ++rbl)
#pragma unroll
            for (int ks = 0; ks < 4; ++ks) {
                const LAS unsigned short* base = (const LAS unsigned short*)(lds + ((2 * ks + (fq >> 1)) * 8 + w) * 1024) + ((2 * rbl + (fr >> 3)) * 16 + 8 * (fq & 1)) * 8 + (fr & 7);
                bf16x8 v;
#pragma unroll
                for (int jj = 0; jj < 8; ++jj) v[jj] = (short)base[jj * 8];
                af[rbl][ks] = v;
            }
#pragma unroll 1
        for (int p = 0; p < 4; ++p) {
            LAS unsigned char* buf = lds + 65536 + (p & 1) * 32768;
            if (p + 1 < 4) R1_DMA(p + 1, 65536 + ((p + 1) & 1) * 32768);
            f32x4 acc[2][8];
#pragma unroll
            for (int rbl = 0; rbl < 2; ++rbl)
#pragma unroll
                for (int cb = 0; cb < 8; ++cb) acc[rbl][cb] = (f32x4){0.f, 0.f, 0.f, 0.f};
#pragma unroll
            for (int cb = 0; cb < 8; ++cb)
#pragma unroll
                for (int ks = 0; ks < 4; ++ks) {
                    const bf16x8 vf = *(const LAS bf16x8*)(buf + (cb * 4 + ks) * 1024 + lane * 16);
                    acc[0][cb] = MFMA16(af[0][ks], vf, acc[0][cb]); acc[1][cb] = MFMA16(af[1][ks], vf, acc[1][cb]);
                }
#pragma unroll
            for (int rbl = 0; rbl < 2; ++rbl)
#pragma unroll
                for (int cb = 0; cb < 8; ++cb) {
                    const f32x4 a = acc[rbl][cb];
                    *(u32x2*)(KV + (size_t)u * 131072 + ((8 * p + cb) * 8 + w) * 512 + ((2 * rbl + (fq >> 1)) * 16 + fr) * 8 + 4 * (fq & 1)) = (u32x2){pk2(a[0], a[1]), pk2(a[2], a[3])};
                }
            asm volatile("s_waitcnt vmcnt(0)" ::: "memory");
            __syncthreads();
        }
    }
}
__device__ __forceinline__ void r2_phase(bf16* KV, int gt, int ngt) {
    for (int it = gt; it < 131072; it += ngt) {
        const int h = it >> 15, rem = it & 32767;
        const float gC = exp2f(128.0f * log2f(1.0f - exp2f(-5.0f - (float)h)));
        float s0 = 0.f, s1 = 0.f, s2 = 0.f, s3 = 0.f;
        bf16* base = KV + (size_t)h * 64 * 131072 + (size_t)rem * 4;
        for (int n0 = 0; n0 < 64; n0 += 8) {
            u32x2 kv[8];
#pragma unroll
            for (int q = 0; q < 8; ++q) kv[q] = *(const u32x2*)(base + (size_t)(n0 + q) * 131072);
#pragma unroll
            for (int q = 0; q < 8; ++q) {
                *(u32x2*)(base + (size_t)(n0 + q) * 131072) = (u32x2){pk2(s0, s1), pk2(s2, s3)};
                s0 = s0 * gC + __builtin_bit_cast(float, kv[q].x << 16); s1 = s1 * gC + __builtin_bit_cast(float, kv[q].x & 0xffff0000u);
                s2 = s2 * gC + __builtin_bit_cast(float, kv[q].y << 16); s3 = s3 * gC + __builtin_bit_cast(float, kv[q].y & 0xffff0000u);
            }
        }
    }
}
__device__ __forceinline__ const char* r3_stage_src(int s, const char* kb, const char* st, const char* vt, int c) {
    const int slot = c >> 6, lp = (c & 63) * 16;
    if (s < 2) return kb + (size_t)((4 * s + (slot >> 3)) * 32 + (slot & 7)) * 1024 + lp;
    if (s < 10) return st + (size_t)(s - 2) * 32768 + (size_t)c * 16;
    return vt + (size_t)slot * 262144 + (size_t)(s - 10) * 1024 + lp;
}
__device__ __forceinline__ void r3_phase(const bf16* Q, const bf16* Kb, const bf16* VT, const bf16* ST, bf16* Gb, LAS unsigned char* lds, int bid, int G, int tid_, int w, int lane_) {
    LAS bf16* sw = (LAS bf16*)(lds + 65536 + w * 4352);
    LAS bf16* ow = (LAS bf16*)(lds + w * 8448);
    for (int u = bid; u < 256; u += G) {
        int tid = tid_, lane = lane_; asm volatile("" : "+v"(tid), "+v"(lane));
        const int fr = lane & 15, fq = lane >> 4;
        const int h = u >> 6, n = u & 63;
        const float lg = log2f(1.0f - exp2f(-5.0f - (float)h));
        const char* kbu = (const char*)(Kb + ((size_t)(8 * n) * 32 + 8 * h) * 512);
        const char* stu = (const char*)(ST + (size_t)u * 131072);
        const char* vtu = (const char*)(VT + ((size_t)(32 * h) * 256 + 4 * n) * 512);
        bf16x8 qf[8];
        { const char* qtu = (const char*)(Q + ((size_t)(8 * n + w) * 32 + 8 * h) * 512);
#pragma unroll
          for (int ks = 0; ks < 8; ++ks) qf[ks] = *(const bf16x8*)(qtu + ks * 1024 + lane * 16); }
#define R3_DMA(sg, bufoff) do { _Pragma("unroll") for (int q_ = 0; q_ < 4; ++q_) \
        __builtin_amdgcn_global_load_lds((const unsigned*)r3_stage_src((sg), kbu, stu, vtu, (4 * w + q_) * 64 + lane), (LAS unsigned*)(lds + (bufoff) + (4 * w + q_) * 1024), 16, 0, 0); } while (0)
        R3_DMA(0, 0);
        asm volatile("s_waitcnt vmcnt(0)" ::: "memory");
        __syncthreads();
        const int jbmax = w | 1, ksmax = w >> 1;
        f32x4 as[8];
#pragma unroll
        for (int jb = 0; jb < 8; ++jb) as[jb] = (f32x4){0.f, 0.f, 0.f, 0.f};
        f32x4 o[32];
#pragma unroll
        for (int s = 0; s < 14; ++s) {
            LAS unsigned char* buf = lds + (s & 1) * 32768;
            if (s + 1 < 14) R3_DMA(s + 1, ((s + 1) & 1) * 32768);
            if (s < 2) {
#pragma unroll
                for (int jl = 0; jl < 4; ++jl)
                    if (4 * s + jl <= jbmax) {
#pragma unroll
                        for (int ks = 0; ks < 8; ++ks) { const bf16x8 kf = *(const LAS bf16x8*)(buf + (jl * 8 + ks) * 1024 + lane * 16); as[4 * s + jl] = MFMA16(qf[ks], kf, as[4 * s + jl]); }
                        asm volatile("" ::: "memory");
                    }
                if (s == 1) {
#pragma unroll
                    for (int jb = 0; jb < 8; ++jb)
                        if (jb <= jbmax) {
#pragma unroll
                            for (int ii = 0; ii < 4; ++ii) {
                                const int i = 16 * w + 4 * fq + ii, j = 16 * jb + fr;
                                const float v = (i >= j) ? as[jb][ii] * __builtin_amdgcn_exp2f(lg * (float)(i - 127)) : 0.f;
                                sw[(4 * fq + ii) * 136 + j] = (bf16)f2bf(v);
                            }
                        }
                }
            } else if (s < 10) {
                if (s == 2) {
#pragma unroll
                    for (int eb = 0; eb < 32; ++eb) o[eb] = (f32x4){0.f, 0.f, 0.f, 0.f};
                }
#pragma unroll
                for (int el = 0; el < 4; ++el)
#pragma unroll
                    for (int ks = 0; ks < 8; ++ks) { const bf16x8 sf = *(const LAS bf16x8*)(buf + (el * 8 + ks) * 1024 + lane * 16); o[4 * (s - 2) + el] = MFMA16(qf[ks], sf, o[4 * (s - 2) + el]); if ((ks & 3) == 3) asm volatile("" ::: "memory"); }
                if (s == 9) {
                    float qd[4];
#pragma unroll
                    for (int ii = 0; ii < 4; ++ii) qd[ii] = __builtin_amdgcn_exp2f(lg * (float)(16 * w + 4 * fq + ii + 1));
#pragma unroll
                    for (int eb = 0; eb < 32; ++eb)
#pragma unroll
                        for (int ii = 0; ii < 4; ++ii) o[eb][ii] *= qd[ii];
                }
            } else {
                if (s - 10 <= ksmax) {
                    const bf16x8 af = *(const LAS bf16x8*)(sw + fr * 136 + 32 * (s - 10) + 8 * fq);
#pragma unroll
                    for (int eb = 0; eb < 32; ++eb) { const bf16x8 vf = *(const LAS bf16x8*)(buf + eb * 1024 + lane * 16); o[eb] = MFMA16(af, vf, o[eb]); if ((eb & 7) == 7) asm volatile("" ::: "memory"); }
                }
            }
            asm volatile("s_waitcnt vmcnt(0)" ::: "memory");
            __syncthreads();
        }
        float mean[4], rstd[4];
#pragma unroll
        for (int ii = 0; ii < 4; ++ii) {
            float sm = 0.f;
#pragma unroll
            for (int eb = 0; eb < 32; ++eb) sm += o[eb][ii];
            sm += shx(sm, 1, lane); sm += shx(sm, 2, lane); sm += shx(sm, 4, lane); sm += shx(sm, 8, lane);
            const float mu = sm * (1.0f / 512.0f); float q = 0.f;
#pragma unroll
            for (int eb = 0; eb < 32; ++eb) { const float dd = o[eb][ii] - mu; q += dd * dd; }
            q += shx(q, 1, lane); q += shx(q, 2, lane); q += shx(q, 4, lane); q += shx(q, 8, lane);
            mean[ii] = mu; rstd[ii] = __builtin_amdgcn_rsqf(q * (1.0f / 512.0f) + 1e-5f);
        }
#pragma unroll
        for (int hf = 0; hf < 2; ++hf) {
#pragma unroll
            for (int e2 = 0; e2 < 16; ++e2)
#pragma unroll
                for (int ii = 0; ii < 4; ++ii) { ow[(4 * fq + ii) * 264 + 16 * e2 + fr] = (bf16)f2bf((o[16 * hf + e2][ii] - mean[ii]) * rstd[ii]); if (ii == 3 && (e2 & 3) == 3) asm volatile("" ::: "memory"); }
            __syncthreads();
#pragma unroll 1
            for (int qh = 0; qh < 2; ++qh) {
                u32x4 gq[4];
#pragma unroll
                for (int q4 = 0; q4 < 4; ++q4) { const int c = lane + 64 * (4 * qh + q4); gq[q4] = *(const u32x4*)(Gb + (size_t)(128 * n + 16 * w + (c >> 5)) * 2048 + 512 * h + 256 * hf + 8 * (c & 31)); }
#pragma unroll
                for (int q4 = 0; q4 < 4; ++q4) {
                    const int c = lane + 64 * (4 * qh + q4), row = c >> 5, c8 = c & 31;
                    const u32x4 ov = *(const LAS u32x4*)(ow + row * 264 + 8 * c8);
                    bf16* gp = Gb + (size_t)(128 * n + 16 * w + row) * 2048 + 512 * h + 256 * hf + 8 * c8;
                    const u32x4 gv = gq[q4];
                    u32x4 r;
#pragma unroll
                    for (int t = 0; t < 4; ++t) {
                        const float a0 = __builtin_bit_cast(float, ov[t] << 16) * __builtin_bit_cast(float, gv[t] << 16);
                        const float a1 = __builtin_bit_cast(float, ov[t] & 0xffff0000u) * __builtin_bit_cast(float, gv[t] & 0xffff0000u);
                        r[t] = pk2(a0, a1);
                    }
                    *(u32x4*)gp = r;
                }
            }
            __syncthreads();
        }
    }
}

#define XB_TMO      128
#define XB_XCNT(j)  (256  + 64 * (j))
#define XB_XSUB(j)  (1280 + 64 * (j))
#define XB_XGEN(j)  (2304 + 64 * (j))
#define XB_TOP      3328
#define XB_TOPGEN   3392
#define XCD_BAR_WORDS 3456
#define XB_SPIN_CAP (1u << 18)

__device__ __forceinline__ unsigned xb_ld(unsigned* p)              { return __hip_atomic_load(p, __ATOMIC_RELAXED, __HIP_MEMORY_SCOPE_AGENT); }
__device__ __forceinline__ unsigned xb_add(unsigned* p, unsigned v) { return __hip_atomic_fetch_add(p, v, __ATOMIC_RELAXED, __HIP_MEMORY_SCOPE_AGENT); }
__device__ __forceinline__ unsigned xb_xcc_id() { return (unsigned)__builtin_amdgcn_s_getreg((3 << 11) | 20) & 0xFu; }
#define XB_SPIN(cond, bar) do { unsigned _sp = 0; while (cond) { __builtin_amdgcn_s_sleep(1); \
    if ((++_sp & 255u) == 0u) { if (xb_ld(&(bar)[XB_TMO])) break; if (_sp > XB_SPIN_CAP) { atomicAdd(&(bar)[XB_TMO], 1u); break; } } } } while (0)

struct XcdBarrier {
    unsigned* bar; unsigned x;
    volatile LAS unsigned* st;
};

__device__ __forceinline__ XcdBarrier xcd_barrier_post(unsigned* bar, volatile LAS unsigned* st) {
    XcdBarrier b; b.bar = bar; b.x = xb_xcc_id(); b.st = st;
    if (threadIdx.x == 0) (void)xb_add(&bar[XB_XCNT(b.x)], 1u);
    return b;
}
__device__ __forceinline__ void xcd_barrier_complete(unsigned* bar, unsigned x, unsigned& nloc, unsigned& nx) {
    const unsigned G = gridDim.x * gridDim.y * gridDim.z;
    unsigned sum, cnt, mine, sp = 0u;
    for (;;) {
        sum = 0u; cnt = 0u; mine = 0u;
#pragma unroll
        for (unsigned j = 0; j < 16; ++j) { const unsigned c = xb_ld(&bar[XB_XCNT(j)]); sum += c; cnt += (c > 0u) ? 1u : 0u; mine = (j == x) ? c : mine; }
        if (sum == G) break;
        __builtin_amdgcn_s_sleep(1);
        if ((++sp & 255u) == 0u) { if (xb_ld(&bar[XB_TMO])) break; if (sp > XB_SPIN_CAP) { atomicAdd(&bar[XB_TMO], 1u); break; } }
    }
    nloc = mine > 0u ? mine : 1u; nx = cnt > 0u ? cnt : 1u;
}

__device__ __forceinline__ void xcd_barrier(const XcdBarrier& b) {
    asm volatile("s_waitcnt vmcnt(0)" ::: "memory");
    __syncthreads();
    if (threadIdx.x == 0) {
        unsigned* bar = b.bar;
        __builtin_amdgcn_s_waitcnt(0);
        unsigned nloc = b.st[0], nx = b.st[1];
        if (nloc == 0u) { xcd_barrier_complete(bar, b.x, nloc, nx); b.st[0] = nloc; b.st[1] = nx; }
        const unsigned old = xb_add(&bar[XB_XSUB(b.x)], 1u);
        const unsigned gen = old / nloc;
        if (old + 1u == (gen + 1u) * nloc) {
            __builtin_amdgcn_fence(__ATOMIC_RELEASE, "agent");
            asm volatile("s_waitcnt vmcnt(0)" ::: "memory");
            const unsigned og = xb_add(&bar[XB_TOP], 1u);
            const unsigned tg = og / nx;
            if (og + 1u == (tg + 1u) * nx) xb_add(&bar[XB_TOPGEN], 1u);
            else XB_SPIN(xb_ld(&bar[XB_TOPGEN]) == tg, bar);
            __builtin_amdgcn_fence(__ATOMIC_ACQUIRE, "agent");
            xb_add(&bar[XB_XGEN(b.x)], 1u);
            asm volatile("s_waitcnt vmcnt(0)" ::: "memory");
        } else {
            XB_SPIN(xb_ld(&bar[XB_XGEN(b.x)]) == gen, bar);
            __builtin_amdgcn_fence(__ATOMIC_ACQUIRE, "agent");
            asm volatile("s_waitcnt vmcnt(0)" ::: "memory");
        }
    }
    __syncthreads();
}

__global__ void __launch_bounds__(NTHR, 2) fwd_megakernel(Params P) {
    extern __shared__ __attribute__((aligned(16))) unsigned char lds_raw[];
    LAS unsigned char* lds0 = (LAS unsigned char*)lds_raw;
    cg::grid_group grid = cg::this_grid();
    { volatile LAS unsigned* stw = (volatile LAS unsigned*)(lds0 + 131072 + 256); if (threadIdx.x < 4) stw[threadIdx.x] = 0u; }
    __syncthreads();
    (void)xcd_barrier_post((unsigned*)(P.ws + WS_BAR), (volatile LAS unsigned*)(lds0 + 131072 + 256));
    const int nph = P.nph;
    {
        KP Q0 = (KP)__builtin_amdgcn_kernarg_segment_ptr(); asm volatile("" : "+s"(Q0));
        int tid0 = threadIdx.x; asm volatile("" : "+v"(tid0));
        prologue(Q0, lds0, (int)blockIdx.x, (int)gridDim.x, tid0, __builtin_amdgcn_readfirstlane(tid0 >> 6), tid0 & 63);
        XcdBarrier xb; xb.bar = (unsigned*)(Q0->ws + WS_BAR); xb.x = xb_xcc_id(); xb.st = (volatile LAS unsigned*)(lds0 + 131072 + 256); xcd_barrier(xb);
    }
    for (int ph = 1; ph < nph; ++ph) {
        KP Q = (KP)__builtin_amdgcn_kernarg_segment_ptr(); asm volatile("" : "+s"(Q));
        unsigned char* ws = Q->ws; asm volatile("" : "+s"(ws));
        int bid = blockIdx.x, G = gridDim.x; asm volatile("" : "+s"(bid), "+s"(G));
        LAS unsigned char* lds = lds0; asm volatile("" : "+s"(lds));
#define TLW int tid = threadIdx.x; asm volatile("" : "+v"(tid)); const int lane = tid & 63, w = __builtin_amdgcn_readfirstlane(tid >> 6); (void)lane; (void)w;
#define gw (bid * NWAVES + w)
#define ngw (G * NWAVES)
#define gt (bid * NTHR + tid)
#define ngt (G * NTHR)
#define mods ((float*)(ws + WS_MODS))
#define XN ((bf16*)(ws + WS_XN))
#define XR ((bf16*)Q->out)
#define XF ((bf16*)(ws + WS_BIG + 100 * MiB))
#define scr ((LAS float*)(lds + w * 8704))
#define modl (mods + (size_t)l * 2 * 9216)
        const int kind = Q->ph[ph][0], l = Q->ph[ph][1], sub = Q->ph[ph][2], b = Q->ph[ph][3];
        switch (kind) {
        case K_ROW: { TLW
            if (sub != 1) {
                const int fi = l * 2 + (sub >> 1);
                conv_job(Q->ffn_w_in + (size_t)fi * 1024 * 5632, 1024, 5632, (bf16*)(ws + WS_WB), 1, 2816, scr, gw, ngw, lane);
            } else if (l == 0) {
                conv_job(Q->ret_w_in, 1024, 6144, (bf16*)(ws + WS_WB), 2, 0, scr, gw, ngw, lane);
                conv_job(Q->ret_w_out, 2048, 1024, (bf16*)(ws + WS_WB2), 0, 0, scr, gw, ngw, lane);
            } else {
                conv_job(Q->w_glu, 1024, 2048, (bf16*)(ws + WS_WB), 1, 1024, scr, gw, ngw, lane);
                s5_build(Q, gt, ngt);
            }
            const void* xin = (l == 0 && sub == 0) ? (const void*)Q->x : (const void*)XR; const int in_f32 = (l == 0 && sub == 0) ? 1 : 0;
            row_pass(xin, in_f32, Q->norm_g + (size_t)(l * 3 + sub) * 1024, modl + 3072 * sub, modl + 3072 * sub + 1024, XN, (l == 1 && sub == 1) ? (bf16*)(ws + WS_XH) : (bf16*)nullptr, (l == 0 && sub == 0) ? XR : (bf16*)nullptr, gw, ngw, lane);
        } break;
        case K_FFN_IN: {
            pg8::Gemm g{XN, (const bf16*)(ws + WS_WB), Mtok, 2 * FF, Dm}; pg8::StaticOrder S; S.init(Mtok, 2 * FF, G, bid);
            pg8::EpiSwiGLU E{(bf16*)(ws + WS_H), FF};
            pg8::gemm_phase<pg8::EpiSwiGLU, pg8::StaticOrder, true, true>(lds, g, S, E);
            { TLW
              const int fi = l * 2 + (sub >> 1);
              if (G == 256) { if (bid >= 128) conv_job(Q->ffn_w_out + (size_t)fi * 2816 * 1024, 2816, 1024, (bf16*)(ws + WS_WB2), 0, 0, scr, (bid - 128) * NWAVES + w, 128 * NWAVES, lane); }
              else conv_job(Q->ffn_w_out + (size_t)fi * 2816 * 1024, 2816, 1024, (bf16*)(ws + WS_WB2), 0, 0, scr, gw, ngw, lane); }
        } break;
        case K_FFN_OUT: case K_RETOUT: {
            const bool isf = kind == K_FFN_OUT;
            pg8::Gemm g{isf ? (const bf16*)(ws + WS_H) : (const bf16*)(ws + WS_G), (const bf16*)(ws + WS_WB2), Mtok, Dm, isf ? FF : 2048}; pg8::StaticOrder S; S.init(Mtok, Dm, G, bid);
            pg8::EpiResid E{XR, (isf && l == 1 && sub == 2) ? XF : XR, modl + 3072 * sub + 2048, isf ? 0.5f : 1.0f};
            pg8::gemm_phase<pg8::EpiResid, pg8::StaticOrder, true, true>(lds, g, S, E);
        } break;
        case K_G3: {
            const float* rot = (const float*)(ws + WS_ROT) + (size_t)b * Lseq * 256;
            { pg8::Gemm g{XN + (size_t)b * Lseq * Dm, (const bf16*)(ws + WS_WB), Lseq, 4096, Dm}; pg8::StaticOrder S; S.init(Lseq, 4096, G, bid);
              pg8::EpiRet3a E{(bf16*)(ws + WS_G) + (size_t)b * Lseq * 2048, (bf16*)(ws + WS_Q), (bf16*)(ws + WS_K), (bf16*)(ws + WS_KT), rot};
              pg8::gemm_phase<pg8::EpiRet3a, pg8::StaticOrder, true, true>(lds, g, S, E); }
            { pg8::Gemm g{(const bf16*)(ws + WS_WB) + (size_t)4096 * Dm, XN + (size_t)b * Lseq * Dm, 2048, Lseq, Dm}; pg8::StaticOrder S; S.init(2048, Lseq, G, bid);
              pg8::EpiRet3b E{(bf16*)(ws + WS_VT)};
              pg8::gemm_phase<pg8::EpiRet3b, pg8::StaticOrder, true, true>(lds, g, S, E); }
        } break;
        case K_R1: { TLW r1_phase((const bf16*)(ws + WS_KT), (const bf16*)(ws + WS_VT), (bf16*)(ws + WS_KV), lds, bid, G, w, lane); } break;
        case K_R2: { TLW r2_phase((bf16*)(ws + WS_KV), gt, ngt); } break;
        case K_R3: { TLW r3_phase((const bf16*)(ws + WS_Q), (const bf16*)(ws + WS_KT), (const bf16*)(ws + WS_VT), (const bf16*)(ws + WS_KV), (bf16*)(ws + WS_G) + (size_t)b * Lseq * 2048, lds, bid, G, tid, w, lane); } break;
        case K_S5A: {
            pg8::Gemm g{(const bf16*)(ws + WS_XH), (const bf16*)(ws + WS_SP), 65536, 256, 384}; pg8::S5Order S{G, bid};
            pg8::EpiS5A E{(float*)(ws + WS_SLOC)};
            pg8::gemm_phase<pg8::EpiS5A, pg8::S5Order, true, true>(lds, g, S, E);
        } break;
        case K_S5B: { TLW s5b_phase((const float*)(ws + WS_SLOC), (const f32x2*)(ws + WS_APW), (bf16*)(ws + WS_XH), lds, bid, G, w, lane); } break;
        case K_S5C: {
            pg8::Gemm g{(const bf16*)(ws + WS_XH), (const bf16*)(ws + WS_TC), 65536, 256, 384}; pg8::S5Order S{G, bid};
            pg8::EpiS5C E{XN, Q->s5_d, (bf16*)(ws + WS_YG)};
            pg8::gemm_phase<pg8::EpiS5C, pg8::S5Order, true, true>(lds, g, S, E);
        } break;
        case K_GLU: {
            pg8::Gemm g{(const bf16*)(ws + WS_YG), (const bf16*)(ws + WS_WB), Mtok, 2048, Dm}; pg8::StaticOrder S; S.init(Mtok, 2048, G, bid);
            pg8::EpiGLU E{XR, modl + 3072 + 2048};
            pg8::gemm_phase<pg8::EpiGLU, pg8::StaticOrder, true, true>(lds, g, S, E);
        } break;
        case K_FINAL: { TLW final_norm(XF, Q->out, Q->final_g, gw, ngw, lane); } break;
        default: break;
        }
        if (ph + 1 < nph) { if (nph > MAXPH) grid.sync();   else { XcdBarrier xb; xb.bar = (unsigned*)(ws + WS_BAR); xb.x = xb_xcc_id(); xb.st = (volatile LAS unsigned*)(lds + 131072 + 256); xcd_barrier(xb); } }
    }
}

#undef TLW
#undef gw
#undef ngw
#undef gt
#undef ngt
#undef mods
#undef XN
#undef XR
#undef XF
#undef scr
#undef modl
extern "C" void kernel_launch(void* const* d_in, const int* in_sizes, int n_in, void* d_out, int out_size, void* d_ws, size_t ws_size, hipStream_t stream) {
    static int grid = 0;
    if (grid == 0) {
        if (n_in != 20 || in_sizes[0] != Mtok * Dm || out_size != Mtok * Dm || ws_size < WS_END) {
            fprintf(stderr, "kernel_launch: unexpected problem (n_in %d, in0 %d, out %d, ws %zu, need %zu); nothing launched\n", n_in, n_in > 0 ? in_sizes[0] : -1, out_size, ws_size, (size_t)WS_END);
            grid = -1; return;
        }
        int dev = 0, cus = 0, per_cu = 0;
        hipGetDevice(&dev);
        hipDeviceGetAttribute(&cus, hipDeviceAttributeMultiprocessorCount, dev);
        hipFuncSetAttribute((const void*)fwd_megakernel, hipFuncAttributeMaxDynamicSharedMemorySize, LDS_BYTES);
        hipOccupancyMaxActiveBlocksPerMultiprocessor(&per_cu, (const void*)fwd_megakernel, NTHR, LDS_BYTES);
        if (per_cu < 1) { fprintf(stderr, "kernel_launch: occupancy query reports %d blocks per CU; nothing launched\n", per_cu); grid = -1; return; }
        grid = cus;
        fprintf(stderr, "kernel_launch: grid %d (per_cu %d), ws %zu\n", grid, per_cu, ws_size);
    }
    if (grid < 0) return;
    Params p{};
    p.x = (const float*)d_in[0]; p.c = (const float*)d_in[1]; p.pos = (const int*)d_in[2]; p.ada_w = (const float*)d_in[3]; p.ada_b = (const float*)d_in[4];
    p.norm_g = (const float*)d_in[5]; p.ffn_w_in = (const float*)d_in[6]; p.ffn_w_out = (const float*)d_in[7]; p.ret_w_in = (const float*)d_in[8]; p.ret_w_out = (const float*)d_in[9];
    p.a_re = (const float*)d_in[10]; p.a_im = (const float*)d_in[11]; p.b_re = (const float*)d_in[12]; p.b_im = (const float*)d_in[13]; p.c_re = (const float*)d_in[14]; p.c_im = (const float*)d_in[15];
    p.s5_d = (const float*)d_in[16]; p.log_dt = (const float*)d_in[17]; p.w_glu = (const float*)d_in[18]; p.final_g = (const float*)d_in[19];
    p.out = (float*)d_out; p.ws = (unsigned char*)d_ws;
    int n = 0;
    auto add = [&](int k, int l, int s, int b) { p.ph[n][0] = (unsigned char)k; p.ph[n][1] = (unsigned char)l; p.ph[n][2] = (unsigned char)s; p.ph[n][3] = (unsigned char)b; ++n; };
#ifndef EXP
#define EXP 0
#endif
    const int rPRO = (EXP == 1) ? 2 : 1, rROW = (EXP == 1) ? 2 : 1, rRET = (EXP == 2) ? 2 : 1, rS5 = (EXP == 3) ? 2 : 1, rFIN = (EXP == 4) ? 2 : 1;
    for (int r = 0; r < rPRO; ++r) add(K_PRO, 0, 0, 0);
    for (int l = 0; l < 2; ++l)
        for (int s = 0; s < 3; ++s) {
            for (int r = 0; r < rROW; ++r) add(K_ROW, l, s, 0);
            if (s != 1) { for (int r = 0; r < rFIN; ++r) add(K_FFN_IN, l, s, 0); add(K_FFN_OUT, l, s, 0); }
            else if (l == 0) { for (int b = 0; b < 2; ++b) for (int r = 0; r < rRET; ++r) { add(K_G3, 0, 1, b); add(K_R1, 0, 1, b); add(K_R2, 0, 1, b); add(K_R3, 0, 1, b); } add(K_RETOUT, 0, 1, 0); }
            else { for (int r = 0; r < rS5; ++r) add(K_S5A, 1, 1, 0); for (int r = 0; r < rS5; ++r) add(K_S5B, 1, 1, 0); for (int r = 0; r < rS5; ++r) add(K_S5C, 1, 1, 0); add(K_GLU, 1, 1, 0); }
        }
    add(K_FINAL, 0, 0, 0);
    p.nph = n;
    hipMemsetAsync((char*)d_ws + WS_BAR, 0, 16384, stream);
    void* args[] = {&p};
    hipError_t e = hipLaunchCooperativeKernel((const void*)fwd_megakernel, dim3(grid), dim3(NTHR), args, LDS_BYTES, stream);
    if (e != hipSuccess) fprintf(stderr, "kernel_launch: cooperative launch failed: %s (grid %d)\n", hipGetErrorString(e), grid);
}
```

```cpp
#include <hip/hip_runtime.h>
#include <hip/hip_cooperative_groups.h>
#include <cstdio>
#include <cstdint>
namespace cg = cooperative_groups;
namespace pg8 {
#define PG8_LAS __attribute__((address_space(3)))
typedef unsigned short bf16_t;
typedef short bf16x8 __attribute__((ext_vector_type(8)));
typedef float f32x4 __attribute__((ext_vector_type(4)));
typedef unsigned u32x4 __attribute__((ext_vector_type(4)));
constexpr int BM = 256, BK = 64, HALF = 128, HTB = HALF * BK * 2  , STAGE_BYTES = 8 * HTB, NXCD = 8, WGM = 8;

__host__ __device__ __forceinline__ int lds_byte(int r, int c) { const int st = (r >> 4) * 2 + (c >> 5), rr = r & 15, cc = c & 31, ob = rr * 64 + cc * 2; return st * 1024 + (ob ^ (((ob >> 9) & 1) << 5)); }
__host__ __device__ __forceinline__ void stage_rc(int b, int& R, int& C) { const int st = b / 1024, sb = b % 1024, swz = sb ^ (((sb >> 9) & 1) << 5); R = (st >> 1) * 16 + swz / 64; C = (st & 1) * 32 + (swz % 64) / 2; }
__host__ __device__ __forceinline__ int perm32(int rho) { const int n = rho >> 4, i = rho & 15; return 8 * (i >> 2) + 4 * n + (i & 3); }

struct Unit { int pm, pn; };
struct Gemm { const bf16_t* A; const bf16_t* Bt; int M, N, K; };

struct StaticOrder {
    int nM, nN, nwg, G, c;
    __host__ __device__ void init(int M, int N, int G_, int c_) { nM = M / BM; nN = N / BM; nwg = nM * nN; G = G_; c = c_; }
    __host__ __device__ bool next(int i, Unit& u) const {
        const long L = (long)i * G + c; if (L >= nwg) return false;
        int wgid = (int)L; { const int q = nwg / NXCD, r = nwg % NXCD, xcd = wgid % NXCD, off = wgid / NXCD; wgid = (xcd < r ? xcd * (q + 1) : r * (q + 1) + (xcd - r) * q) + off; }
        const int nig = WGM * nN, gid = wgid / nig, fm = gid * WGM, gsz = (nM - fm) < WGM ? (nM - fm) : WGM;
        u.pm = fm + ((wgid % nig) % gsz); u.pn = (wgid % nig) / gsz; return true;
    }
    __device__ __forceinline__ void a_ready(const Unit&) const {}
    __device__ __forceinline__ void done(const Unit&) const {}
};
__device__ __forceinline__ unsigned cvt_pk_bf16(float lo, float hi) { unsigned r; asm volatile("v_cvt_pk_bf16_f32 %0, %1, %2" : "=v"(r) : "v"(lo), "v"(hi)); return r; }
typedef float f32x2 __attribute__((ext_vector_type(2)));
typedef unsigned u32x2 __attribute__((ext_vector_type(2)));
typedef _Float16 h16x4 __attribute__((ext_vector_type(4)));
__device__ __forceinline__ float silu_f(float v) { return v * __builtin_amdgcn_rcpf(1.f + __expf(-v)); }
__device__ __forceinline__ float sigm_f(float v) { return __builtin_amdgcn_rcpf(1.f + __expf(-v)); }
__device__ __forceinline__ u32x4 pack8(f32x4 a, f32x4 b) { u32x4 w; w.x = cvt_pk_bf16(a[0], a[1]); w.y = cvt_pk_bf16(a[2], a[3]); w.z = cvt_pk_bf16(b[0], b[1]); w.w = cvt_pk_bf16(b[2], b[3]); return w; }

struct EpiSwiGLU {
    static constexpr bool PERM = true, AFTER_DRAIN = false;
    bf16_t* O; int ldc;
    __device__ __forceinline__ void operator()(const f32x4 (&acc)[2][2][4][2], const Unit& u, int wr, int wc, int fr, int fq) const {
        asm volatile("" : "+v"(fr), "+v"(fq));
        const int row0 = u.pm * BM + wr * 64 + fr, col0 = u.pn * HALF + wc * 32 + 8 * fq;
#pragma unroll
        for (int ai = 0; ai < 2; ++ai)
#pragma unroll
            for (int m = 0; m < 4; ++m) {
                bf16_t* rowp = O + (size_t)(row0 + ai * HALF + m * 16) * ldc + col0;
                f32x4 o0, o1;
#pragma unroll
                for (int i = 0; i < 4; ++i) { o0[i] = silu_f(acc[ai][0][m][0][i]) * acc[ai][1][m][0][i]; o1[i] = silu_f(acc[ai][0][m][1][i]) * acc[ai][1][m][1][i]; }
                *(u32x4*)rowp = pack8(o0, o1);
            }
    }
};
struct EpiResid {
    static constexpr bool PERM = false, AFTER_DRAIN = true;
    const bf16_t* base; bf16_t* out; const float* gate; float gs;
    __device__ __forceinline__ void fused(f32x4 (&acc)[2][2][4][2], const Unit& u, int wr, int wc, int fr, int fq, PG8_LAS unsigned char* lds, int wid, int lane) const {
        asm volatile("" : "+v"(fr), "+v"(fq), "+v"(lane));
        PG8_LAS float* T = (PG8_LAS float*)lds;
        const int b = u.pm >> 5;
        const f32x4 gv = *(const f32x4*)(gate + b * 9216 + u.pn * BM + 4 * lane) * gs;
        h16x4 bsr[4][8];
#pragma unroll
        for (int ps = 0; ps < 4; ++ps)
#pragma unroll
            for (int q = 0; q < 8; ++q) {
                const int rl = wid * 8 + q, actual = (ps >> 1) * HALF + 64 * (rl >> 5) + 16 * (2 * (ps & 1) + ((rl >> 4) & 1)) + (rl & 15);
                bsr[ps][q] = *(const h16x4*)(base + (size_t)(u.pm * BM + actual) * 1024 + u.pn * BM + 4 * lane);
            }
#pragma unroll
        for (int ai = 0; ai < 2; ++ai)
#pragma unroll
            for (int mh = 0; mh < 2; ++mh) {
#pragma unroll
                for (int mp = 0; mp < 2; ++mp)
#pragma unroll
                    for (int bj = 0; bj < 2; ++bj)
#pragma unroll
                        for (int n = 0; n < 2; ++n)
                            *(PG8_LAS f32x4*)(T + (wr * 32 + mp * 16 + fr) * 272 + bj * HALF + wc * 32 + n * 16 + 4 * fq) = acc[ai][bj][2 * mh + mp][n];
                __syncthreads();
#pragma unroll
                for (int q = 0; q < 8; ++q) {
                    const int rl = wid * 8 + q, actual = ai * HALF + 64 * (rl >> 5) + 16 * (2 * mh + ((rl >> 4) & 1)) + (rl & 15);
                    const size_t off = (size_t)(u.pm * BM + actual) * 1024 + u.pn * BM + 4 * lane;
                    const f32x4 bs = __builtin_convertvector(bsr[2 * ai + mh][q], f32x4);
                    const f32x4 o = bs + gv * *(const PG8_LAS f32x4*)(T + rl * 272 + 4 * lane);
                    *(h16x4*)(out + off) = __builtin_convertvector(o, h16x4);
                }
                __syncthreads();
            }
    }
};
struct EpiGLU {
    static constexpr bool PERM = true, AFTER_DRAIN = false;
    bf16_t* xr; const float* gate;
    __device__ __forceinline__ void operator()(const f32x4 (&acc)[2][2][4][2], const Unit& u, int wr, int wc, int fr, int fq) const {
        asm volatile("" : "+v"(fr), "+v"(fq));
        const int b = u.pm >> 5, col = u.pn * HALF + wc * 32 + 8 * fq;
        const f32x4 g0 = *(const f32x4*)(gate + b * 9216 + col), g1 = *(const f32x4*)(gate + b * 9216 + col + 4);
#pragma unroll
        for (int ai = 0; ai < 2; ++ai)
#pragma unroll
            for (int m = 0; m < 4; ++m) {
                const size_t off = (size_t)(u.pm * BM + ai * HALF + wr * 64 + m * 16 + fr) * 1024 + col;
                const f32x4 r0 = __builtin_convertvector(*(const h16x4*)(xr + off), f32x4), r1 = __builtin_convertvector(*(const h16x4*)(xr + off + 4), f32x4);
                f32x4 o0, o1;
#pragma unroll
                for (int t = 0; t < 4; ++t) {
                    o0[t] = r0[t] + g0[t] * (acc[ai][0][m][0][t] * sigm_f(acc[ai][1][m][0][t]));
                    o1[t] = r1[t] + g1[t] * (acc[ai][0][m][1][t] * sigm_f(acc[ai][1][m][1][t]));
                }
                *(h16x4*)(xr + off) = __builtin_convertvector(o0, h16x4); *(h16x4*)(xr + off + 4) = __builtin_convertvector(o1, h16x4);
            }
    }
};
struct EpiRet3a {
    static constexpr bool PERM = true, AFTER_DRAIN = false;
    bf16_t* G; bf16_t* Q; bf16_t* K; bf16_t* KD; const float* rot;
    __device__ __forceinline__ void operator()(const f32x4 (&acc)[2][2][4][2], const Unit& u, int wr, int wc, int fr, int fq) const {
        asm volatile("" : "+v"(fr), "+v"(fq));
        const int row0 = u.pm * BM + wr * 64 + fr;
        if (u.pn < 8) {
            const int col0 = u.pn * BM + wc * 32 + 8 * fq;
#pragma unroll
            for (int ai = 0; ai < 2; ++ai)
#pragma unroll
                for (int m = 0; m < 4; ++m)
#pragma unroll
                    for (int bj = 0; bj < 2; ++bj) {
                        f32x4 o0, o1;
#pragma unroll
                        for (int i = 0; i < 4; ++i) { o0[i] = silu_f(acc[ai][bj][m][0][i]); o1[i] = silu_f(acc[ai][bj][m][1][i]); }
                        *(u32x4*)(G + (size_t)(row0 + ai * HALF + m * 16) * 2048 + col0 + bj * HALF) = pack8(o0, o1);
                    }
        } else {
            const int h = (u.pn - 8) & 3; const bool isk = u.pn >= 12; bf16_t* dst = isk ? K : Q; const float sc = isk ? 0.0625f : 1.0f;
            const int d0 = wc * 32 + 8 * fq;
#pragma unroll
            for (int ai = 0; ai < 2; ++ai)
#pragma unroll
                for (int m = 0; m < 4; ++m) {
                    const int row = row0 + ai * HALF + m * 16;
                    const f32x4* rp = (const f32x4*)(rot + ((size_t)row * 128 + d0) * 2);
                    f32x4 o1[2], o2[2];
#pragma unroll
                    for (int n = 0; n < 2; ++n) {
                        const f32x4 r0 = rp[2 * n], r1 = rp[2 * n + 1];
                        const f32x4 c = {r0[0], r0[2], r1[0], r1[2]}, s = {r0[1], r0[3], r1[1], r1[3]};
                        const f32x4 t1 = acc[ai][0][m][n], t2 = acc[ai][1][m][n];
                        o1[n] = (t1 * c - t2 * s) * sc; o2[n] = (t1 * s + t2 * c) * sc;
                    }
                    const size_t po = ((size_t)(row >> 4) * 32 + 8 * h + wc) * 512 + (fq * 16 + (row & 15)) * 8;
                    const float dec = isk ? __builtin_amdgcn_exp2f(log2f(1.0f - exp2f(-5.0f - (float)h)) * (float)(127 - (row & 127))) : 1.0f;
                    bf16_t* p = (isk ? KD : Q) + po;
                    *(u32x4*)p = pack8(o1[0] * dec, o1[1] * dec); *(u32x4*)(p + 4 * 512) = pack8(o2[0] * dec, o2[1] * dec);
                    if (m & 1) asm volatile("" ::: "memory");
                }
        }
    }
};
struct EpiRet3b {
    static constexpr bool PERM = true, AFTER_DRAIN = false;
    bf16_t* VT;
    __device__ __forceinline__ void operator()(const f32x4 (&acc)[2][2][4][2], const Unit& u, int wr, int wc, int fr, int fq) const {
        asm volatile("" : "+v"(fr), "+v"(fq));
        const int f0 = u.pm * BM + wr * 64 + fr, t0 = u.pn * BM + wc * 32 + 8 * fq;
#pragma unroll
        for (int ai = 0; ai < 2; ++ai)
#pragma unroll
            for (int m = 0; m < 4; ++m)
#pragma unroll
                for (int bj = 0; bj < 2; ++bj)
                    *(u32x4*)(VT + ((size_t)((f0 + ai * HALF + m * 16) >> 4) * 256 + ((t0 + bj * HALF) >> 5)) * 512 + (fq * 16 + fr) * 8) = pack8(acc[ai][bj][m][0], acc[ai][bj][m][1]);
    }
};
struct S5Order {
    int G, c;
    __host__ __device__ bool next(int i, Unit& u) const { const int L = i * G + c; if (L >= 256) return false; u.pm = L; u.pn = L >> 2; return true; }
    __device__ __forceinline__ void a_ready(const Unit&) const {}
    __device__ __forceinline__ void done(const Unit&) const {}
};
struct EpiS5A {
    static constexpr bool PERM = true, AFTER_DRAIN = false;
    float* Sloc;
    __device__ __forceinline__ void operator()(const f32x4 (&acc)[2][2][4][2], const Unit& u, int wr, int wc, int fr, int fq) const {
        asm volatile("" : "+v"(fr), "+v"(fq));
        const int g = u.pn, c0 = (u.pm & 3) * BM + wr * 64 + fr, n0 = wc * 32 + 8 * fq;
#pragma unroll
        for (int ai = 0; ai < 2; ++ai)
#pragma unroll
            for (int m = 0; m < 4; ++m) {
                float* p = Sloc + ((size_t)(c0 + ai * HALF + m * 16) * 64 + g) * 128 + n0;
                *(f32x4*)p = acc[ai][0][m][0]; *(f32x4*)(p + 4) = acc[ai][0][m][1];
            }
    }
};
struct EpiS5C {
    static constexpr bool PERM = true, AFTER_DRAIN = false;
    const bf16_t* XN; const float* dsk; bf16_t* YG;
    __device__ __forceinline__ void operator()(const f32x4 (&acc)[2][2][4][2], const Unit& u, int wr, int wc, int fr, int fq) const {
        asm volatile("" : "+v"(fr), "+v"(fq));
        const int g = u.pn, c0 = (u.pm & 3) * BM + wr * 64 + fr, ch = 16 * g + 8 * (fq & 1);
        const f32x4 d0 = *(const f32x4*)(dsk + ch), d1 = *(const f32x4*)(dsk + ch + 4);
#pragma unroll
        for (int ai = 0; ai < 2; ++ai)
#pragma unroll
            for (int m = 0; m < 4; ++m)
#pragma unroll
                for (int bj = 0; bj < 2; ++bj) {
                    const int i = 8 * bj + 2 * wc + (fq >> 1);
                    const size_t idx = (size_t)(16 * (c0 + ai * HALF + m * 16) + i) * 1024 + ch;
                    const u32x4 uv = *(const u32x4*)(XN + idx);
                    f32x4 y0 = acc[ai][bj][m][0], y1 = acc[ai][bj][m][1];
#pragma unroll
                    for (int t = 0; t < 2; ++t) {
                        y0[2 * t] += d0[2 * t] * __builtin_bit_cast(float, uv[t] << 16); y0[2 * t + 1] += d0[2 * t + 1] * __builtin_bit_cast(float, uv[t] & 0xffff0000u);
                        y1[2 * t] += d1[2 * t] * __builtin_bit_cast(float, uv[2 + t] << 16); y1[2 * t + 1] += d1[2 * t + 1] * __builtin_bit_cast(float, uv[2 + t] & 0xffff0000u);
                    }
#pragma unroll
                    for (int t = 0; t < 4; ++t) {
                        const float a = y0[t], b = y1[t];
                        y0[t] = a * __builtin_amdgcn_rcpf(1.f + __expf(-1.5957691216f * (a + 0.044715f * a * a * a)));
                        y1[t] = b * __builtin_amdgcn_rcpf(1.f + __expf(-1.5957691216f * (b + 0.044715f * b * b * b)));
                    }
                    *(u32x4*)(YG + idx) = pack8(y0, y1);
                }
    }
};
template <class Epi, class Sched, bool ALIGN_EPI = false, bool SP2 = false>
__device__ __forceinline__ void gemm_phase(PG8_LAS unsigned char* lds, const Gemm g, const Sched& S, const Epi& E) {
    int tid_ = threadIdx.x; asm volatile("" : "+v"(tid_));
    const int tid = tid_, wid = __builtin_amdgcn_readfirstlane(tid >> 6), lane = tid & 63, wr = wid >> 2, wc = wid & 3, fr = lane & 15, fq = lane >> 4;
    const int K = g.K, nt = K / BK;
    unsigned voffA[2], voffB[2];
#pragma unroll
    for (int i = 0; i < 2; ++i) { int R, C; stage_rc(tid * 16 + i * 8192, R, C); const int Rb = Epi::PERM ? ((R & ~31) + perm32(R & 31)) : R;
        voffA[i] = (unsigned)(R * K + C) * 2u; voffB[i] = (unsigned)(Rb * K + C) * 2u; }
    const size_t kstep = (size_t)(BK * 2);
    const size_t hstep = (size_t)HALF * K * 2;
    const size_t tstep = 2 * hstep;
    const unsigned ldsw = (unsigned)wid * 1024u;
    const int aoff = lds_byte(wr * 64 + fr, fq * 8), boff = lds_byte(wc * 32 + fr, fq * 8);
#define PG8_SA(b, h) (((b) * 2 + (h)) * HTB)
#define PG8_SB(b, h) ((4 + (b) * 2 + (h)) * HTB)
#define PG8_STAGE(bufoff, gbase, voff) do { _Pragma("unroll") for (int _i = 0; _i < 2; ++_i) \
        __builtin_amdgcn_global_load_lds((const unsigned*)((const char*)(gbase) + (voff)[_i]), (PG8_LAS unsigned*)(lds + (bufoff) + ldsw + _i * 8192), 16, 0, 0); } while (0)
#define PG8_LDA(dst, b, h) do { _Pragma("unroll") for (int m = 0; m < 4; ++m) _Pragma("unroll") for (int k = 0; k < 2; ++k) dst[m][k] = *(const PG8_LAS bf16x8*)(lds + PG8_SA(b, h) + aoff + m * 2048 + k * 1024); } while (0)
#define PG8_LDB(dst, b, h) do { _Pragma("unroll") for (int n = 0; n < 2; ++n) _Pragma("unroll") for (int k = 0; k < 2; ++k) dst[n][k] = *(const PG8_LAS bf16x8*)(lds + PG8_SB(b, h) + boff + n * 2048 + k * 1024); } while (0)
#define PG8_MMA(ai, bj, At, Bt) do { __builtin_amdgcn_s_setprio(1); _Pragma("unroll") for (int m = 0; m < 4; ++m) _Pragma("unroll") for (int n = 0; n < 2; ++n) _Pragma("unroll") for (int k = 0; k < 2; ++k) \
        acc[ai][bj][m][n] = __builtin_amdgcn_mfma_f32_16x16x32_bf16(Bt[n][k], At[m][k], acc[ai][bj][m][n], 0, 0, 0); __builtin_amdgcn_s_setprio(0); } while (0)
#define PG8_WAIT_V(n) asm volatile("s_waitcnt vmcnt(" #n ")" ::: "memory")
#define PG8_WAIT_L(n) asm volatile("s_waitcnt lgkmcnt(" #n ")" ::: "memory")
#define PG8_BAR __builtin_amdgcn_s_barrier()
#define PG8_SCHED __builtin_amdgcn_sched_barrier(0)
    Unit cur, nxt; int ui = 0;
    if (!S.next(0, cur)) return;
    f32x4 acc[2][2][4][2];
#pragma unroll
    for (int a = 0; a < 2; ++a)
#pragma unroll
        for (int b = 0; b < 2; ++b)
#pragma unroll
            for (int m = 0; m < 4; ++m)
#pragma unroll
                for (int n = 0; n < 2; ++n) acc[a][b][m][n] = (f32x4){0.f, 0.f, 0.f, 0.f};
    bf16x8 At[4][2], B0[2][2], B1[2][2];
    const char* cA = (const char*)g.A + (size_t)cur.pm * tstep; const char* cB = (const char*)g.Bt + (size_t)cur.pn * tstep;
    S.a_ready(cur);
    if constexpr (SP2) {
        PG8_STAGE(PG8_SB(0, 0), cB, voffB); PG8_STAGE(PG8_SB(0, 1), cB + hstep, voffB); PG8_STAGE(PG8_SA(0, 0), cA, voffA); PG8_STAGE(PG8_SA(0, 1), cA + hstep, voffA);
        if (wr == 1) PG8_BAR;
        PG8_WAIT_V(2); PG8_BAR;
        PG8_STAGE(PG8_SB(1, 0), cB + kstep, voffB); PG8_STAGE(PG8_SA(1, 0), cA + kstep, voffA); PG8_STAGE(PG8_SB(1, 1), cB + hstep + kstep, voffB);
        PG8_WAIT_V(6); PG8_BAR;
    } else {
        PG8_STAGE(PG8_SB(0, 0), cB, voffB); PG8_STAGE(PG8_SA(0, 0), cA, voffA); PG8_STAGE(PG8_SB(0, 1), cB + hstep, voffB); PG8_STAGE(PG8_SA(0, 1), cA + hstep, voffA);
        if (wr == 1) PG8_BAR;
        PG8_WAIT_V(4); PG8_BAR;
        PG8_STAGE(PG8_SB(1, 0), cB + kstep, voffB); PG8_STAGE(PG8_SA(1, 0), cA + kstep, voffA); PG8_STAGE(PG8_SB(1, 1), cB + hstep + kstep, voffB);
        PG8_WAIT_V(6); PG8_BAR;
    }
    for (;;) {
        const bool has_next = S.next(ui + 1, nxt);
        const char* nA = has_next ? (const char*)g.A + (size_t)nxt.pm * tstep : cA; const char* nB = has_next ? (const char*)g.Bt + (size_t)nxt.pn * tstep : cB;
        for (int t = 0; t < nt; t += 2) {
            const bool last = (t == nt - 2);
            const char* a1 = cA + (size_t)(t + 1) * kstep;
            const char* a2 = last ? nA : cA + (size_t)(t + 2) * kstep; const char* b2 = last ? nB : cB + (size_t)(t + 2) * kstep;
            const char* a3 = a2 + kstep; const char* b3 = b2 + kstep;
            if (last && has_next) S.a_ready(nxt);
            if constexpr (SP2) {
            PG8_LDB(B0, 0, 0); PG8_LDB(B1, 0, 1); PG8_SCHED; PG8_LDA(At, 0, 0); PG8_STAGE(PG8_SA(1, 1), a1 + hstep, voffA);
            PG8_WAIT_V(8); PG8_WAIT_L(0); PG8_BAR; PG8_MMA(0, 0, At, B0); PG8_MMA(0, 1, At, B1); PG8_BAR; PG8_SCHED;
            PG8_LDA(At, 0, 1); PG8_STAGE(PG8_SB(0, 0), b2, voffB); PG8_STAGE(PG8_SB(0, 1), b2 + hstep, voffB); PG8_STAGE(PG8_SA(0, 0), a2, voffA);
            PG8_WAIT_V(8); PG8_WAIT_L(0); PG8_BAR; PG8_MMA(1, 0, At, B0); PG8_MMA(1, 1, At, B1); PG8_BAR; PG8_SCHED;
            PG8_LDB(B0, 1, 0); PG8_LDB(B1, 1, 1); PG8_SCHED; PG8_LDA(At, 1, 0); PG8_STAGE(PG8_SA(0, 1), a2 + hstep, voffA);
            PG8_WAIT_V(8); PG8_WAIT_L(0); PG8_BAR; PG8_MMA(0, 0, At, B0); PG8_MMA(0, 1, At, B1); PG8_BAR; PG8_SCHED;
            PG8_LDA(At, 1, 1); PG8_STAGE(PG8_SB(1, 0), b3, voffB); PG8_STAGE(PG8_SB(1, 1), b3 + hstep, voffB); PG8_STAGE(PG8_SA(1, 0), a3, voffA);
            PG8_WAIT_V(8); PG8_WAIT_L(0); PG8_BAR; PG8_MMA(1, 0, At, B0); PG8_MMA(1, 1, At, B1); PG8_BAR; PG8_SCHED;
            } else {
            PG8_LDB(B0, 0, 0); PG8_SCHED; PG8_LDA(At, 0, 0); PG8_STAGE(PG8_SA(1, 1), a1 + hstep, voffA);
            PG8_WAIT_L(8); PG8_BAR; PG8_WAIT_L(0); PG8_MMA(0, 0, At, B0); PG8_BAR; PG8_SCHED;
            PG8_LDB(B1, 0, 1); PG8_STAGE(PG8_SB(0, 0), b2, voffB);
            PG8_BAR; PG8_WAIT_L(0); PG8_MMA(0, 1, At, B1); PG8_BAR;
            PG8_LDA(At, 0, 1); PG8_STAGE(PG8_SA(0, 0), a2, voffA);
            PG8_BAR; PG8_WAIT_L(0); PG8_MMA(1, 0, At, B0); PG8_BAR; PG8_SCHED;
            PG8_STAGE(PG8_SB(0, 1), b2 + hstep, voffB);
            PG8_WAIT_V(6); PG8_BAR; PG8_MMA(1, 1, At, B1); PG8_BAR;
            PG8_LDB(B0, 1, 0); PG8_SCHED; PG8_LDA(At, 1, 0); PG8_STAGE(PG8_SA(0, 1), a2 + hstep, voffA);
            PG8_WAIT_L(8); PG8_BAR; PG8_WAIT_L(0); PG8_MMA(0, 0, At, B0); PG8_BAR; PG8_SCHED;
            PG8_LDB(B1, 1, 1); PG8_STAGE(PG8_SB(1, 0), b3, voffB);
            PG8_BAR; PG8_WAIT_L(0); PG8_MMA(0, 1, At, B1); PG8_BAR;
            PG8_LDA(At, 1, 1); PG8_STAGE(PG8_SA(1, 0), a3, voffA);
            PG8_BAR; PG8_WAIT_L(0); PG8_MMA(1, 0, At, B0); PG8_BAR; PG8_SCHED;
            PG8_STAGE(PG8_SB(1, 1), b3 + hstep, voffB);
            PG8_WAIT_V(6); PG8_BAR; PG8_MMA(1, 1, At, B1); PG8_BAR;
            }
        }
        if constexpr (ALIGN_EPI) { if (wr == 0) PG8_BAR; }
        if constexpr (!Epi::AFTER_DRAIN) { E(acc, cur, wr, wc, (int)(threadIdx.x & 15u), (int)((threadIdx.x >> 4) & 3u)); S.done(cur); }
        if (!has_next) break;
#pragma unroll
        for (int a = 0; a < 2; ++a)
#pragma unroll
            for (int b = 0; b < 2; ++b)
#pragma unroll
                for (int m = 0; m < 4; ++m)
#pragma unroll
                    for (int n = 0; n < 2; ++n) acc[a][b][m][n] = (f32x4){0.f, 0.f, 0.f, 0.f};
        cur = nxt; cA = nA; cB = nB; ++ui;
        if constexpr (ALIGN_EPI) { if (wr == 1) PG8_BAR; }
    }
    PG8_WAIT_V(0);
    if constexpr (!ALIGN_EPI) { if (wr == 0) PG8_BAR; }
    PG8_BAR;
    if constexpr (Epi::AFTER_DRAIN) { E.fused(acc, cur, wr, wc, (int)(threadIdx.x & 15u), (int)((threadIdx.x >> 4) & 3u), lds, wid, (int)(threadIdx.x & 63u)); S.done(cur); }
#undef PG8_SA
#undef PG8_SB
#undef PG8_STAGE
#undef PG8_LDA
#undef PG8_LDB
#undef PG8_MMA
#undef PG8_WAIT_V
#undef PG8_WAIT_L
#undef PG8_BAR
#undef PG8_SCHED
}
}

#define LAS __attribute__((address_space(3)))
typedef unsigned short bf16;
typedef float f32x4 __attribute__((ext_vector_type(4)));
typedef float f32x2 __attribute__((ext_vector_type(2)));
typedef short bf16x8 __attribute__((ext_vector_type(8)));
typedef unsigned u32x2 __attribute__((ext_vector_type(2)));
typedef unsigned u32x4 __attribute__((ext_vector_type(4)));
typedef _Float16 h16x4 __attribute__((ext_vector_type(4)));

constexpr int NWAVES = 8, NTHR = 512;
constexpr int Mtok = 16384, Dm = 1024, Lseq = 8192, FF = 2816;
constexpr size_t MiB = 1u << 20;
constexpr size_t WS_MODS = 0;
constexpr size_t WS_APW = 256 * 1024;
constexpr size_t WS_EPW = 1024 * 1024;
constexpr size_t WS_BAR = 1792 * 1024;
constexpr size_t WS_WB = 2 * MiB;
constexpr size_t WS_WB2 = 14 * MiB;
constexpr size_t WS_XN = 22 * MiB;
constexpr size_t WS_ROT = 54 * MiB;
constexpr size_t WS_BIG = 70 * MiB;
constexpr size_t WS_H = WS_BIG;
constexpr size_t WS_G = WS_BIG;
constexpr size_t WS_Q = WS_BIG + 64 * MiB;
constexpr size_t WS_K = WS_BIG + 80 * MiB;
constexpr size_t WS_KT = WS_BIG + 96 * MiB;
constexpr size_t WS_VT = WS_BIG + 112 * MiB;
constexpr size_t WS_KV = WS_BIG + 144 * MiB;
constexpr size_t WS_XH = WS_BIG;
constexpr size_t WS_SLOC = WS_BIG + 48 * MiB;
constexpr size_t WS_YG = WS_BIG + 80 * MiB;
constexpr size_t WS_TC = WS_BIG + 112 * MiB;
constexpr size_t WS_SP = WS_BIG + 124 * MiB;
constexpr size_t WS_END = WS_BIG + 208 * MiB;

constexpr int LDS_BYTES = 135168;

__device__ __forceinline__ unsigned f2bf(float f) { unsigned u = __builtin_bit_cast(unsigned, f); return (u + 0x7fffu + ((u >> 16) & 1u)) >> 16; }
__device__ __forceinline__ unsigned pk2(float lo, float hi) { return f2bf(lo) | (f2bf(hi) << 16); }
__device__ __forceinline__ float bf2f(unsigned short h) { return __builtin_bit_cast(float, (unsigned)h << 16); }
__device__ __forceinline__ float shx(float v, int o, int lane) { return __builtin_bit_cast(float, __builtin_amdgcn_ds_bpermute((lane ^ o) << 2, __builtin_bit_cast(int, v))); }
__device__ __forceinline__ float wave_sum(float v, int lane) {
#pragma unroll
    for (int o = 1; o < 64; o <<= 1) v += shx(v, o, lane);
    return v;
}

enum { K_PRO = 0, K_ROW, K_FFN_IN, K_FFN_OUT, K_G3, K_R1, K_R2, K_R3, K_RETOUT, K_S5A, K_S5B, K_S5C, K_GLU, K_FINAL };
constexpr int MAXPH = 64;
struct Params {
    const float* x; const float* c; const int* pos; const float* ada_w; const float* ada_b; const float* norm_g;
    const float* ffn_w_in; const float* ffn_w_out; const float* ret_w_in; const float* ret_w_out;
    const float* a_re; const float* a_im; const float* b_re; const float* b_im; const float* c_re; const float* c_im;
    const float* s5_d; const float* log_dt; const float* w_glu; const float* final_g;
    float* out; unsigned char* ws;
    int nph; int pad;
    unsigned char ph[MAXPH][4];
};

typedef const __attribute__((address_space(4))) Params* KP;

__device__ __forceinline__ int map_row(int mode, int hv, int n) {
    if (mode == 1) { const int up = n >= hv ? 1 : 0, j = n - up * hv; return 256 * (j >> 7) + 128 * up + (j & 127); }
    if (mode == 2) { return n < 4096 ? n + 2048 : n - 4096; }
    return n;
}
__device__ __forceinline__ void conv_item(const float* W, int K, int N, bf16* WT, int mode, int hv, LAS float* scr, int item, int lane) {
    const int nblk = N / 32, kb = item / nblk, nb = item % nblk, k0 = 64 * kb, n0 = 32 * nb;
    float tv[32];
#pragma unroll
    for (int i = 0; i < 32; ++i) tv[i] = __builtin_nontemporal_load(&W[(size_t)(k0 + 2 * i + (lane >> 5)) * N + n0 + (lane & 31)]);
#pragma unroll
    for (int i = 0; i < 32; ++i) scr[(2 * i + (lane >> 5)) * 33 + (lane & 31)] = tv[i];
    asm volatile("s_waitcnt lgkmcnt(0)" ::: "memory");
    const int c = lane & 7;
#pragma unroll
    for (int j = 0; j < 4; ++j) { const int n = (lane >> 3) + 8 * j; const LAS float* s = scr + (8 * c) * 33 + n;
        u32x4 o; o.x = pk2(s[0 * 33], s[1 * 33]); o.y = pk2(s[2 * 33], s[3 * 33]); o.z = pk2(s[4 * 33], s[5 * 33]); o.w = pk2(s[6 * 33], s[7 * 33]);
        *(u32x4*)(WT + (size_t)map_row(mode, hv, n0 + n) * K + k0 + 8 * c) = o; }
    asm volatile("s_waitcnt lgkmcnt(0)" ::: "memory");
}
__device__ __forceinline__ void conv_job(const float* W, int K, int N, bf16* WT, int mode, int hv, LAS float* scr, int gw, int ngw, int lane) {
    const int nitems = (K / 64) * (N / 32);
    for (int it = gw; it < nitems; it += ngw) conv_item(W, K, N, WT, mode, hv, scr, it, lane);
}

__device__ __forceinline__ void row_pass(const void* xin, int in_f32, const float* gvec, const float* sh, const float* sc, bf16* XN, bf16* XH, bf16* XC, int gw, int ngw, int lane) {
    for (int m0 = gw; m0 < Mtok; m0 += 4 * ngw) {
        f32x4 v[4][4]; float s[4];
#pragma unroll
        for (int r = 0; r < 4; ++r) {
            const int m = m0 + r * ngw; const size_t ro = (size_t)(m < Mtok ? m : m0) * Dm;
            if (in_f32) {
#pragma unroll
                for (int j = 0; j < 4; ++j) v[r][j] = __builtin_nontemporal_load((const f32x4*)((const float*)xin + ro) + lane + 64 * j);
            } else {
#pragma unroll
                for (int j = 0; j < 4; ++j) v[r][j] = __builtin_convertvector(*((const h16x4*)((const bf16*)xin + ro) + lane + 64 * j), f32x4);
            }
        }
#pragma unroll
        for (int r = 0; r < 4; ++r) {
            float a = 0.f;
#pragma unroll
            for (int j = 0; j < 4; ++j) a += (v[r][j][0] * v[r][j][0] + v[r][j][1] * v[r][j][1]) + (v[r][j][2] * v[r][j][2] + v[r][j][3] * v[r][j][3]);
            s[r] = 1.0f / sqrtf(wave_sum(a, lane) * (1.0f / Dm) + 1e-6f);
        }
#pragma unroll
        for (int j = 0; j < 4; ++j) {
            const int col = 4 * lane + 256 * j;
            const f32x4 g = *(const f32x4*)(gvec + col);
#pragma unroll
            for (int r = 0; r < 4; ++r) {
                const int m = m0 + r * ngw;
                if (m < Mtok) {
                    const int b = m >> 13;
                    const f32x4 s1 = *(const f32x4*)(sc + b * 9216 + col), s0 = *(const f32x4*)(sh + b * 9216 + col);
                    const f32x4 y = (v[r][j] * s[r] * g) * (s1 + 1.0f) + s0;
                    const unsigned long long pv = (unsigned long long)pk2(y[0], y[1]) | ((unsigned long long)pk2(y[2], y[3]) << 32);
                    *((unsigned long long*)(XN + (size_t)m * Dm) + lane + 64 * j) = pv;
                    if (XC) *((h16x4*)(XC + (size_t)m * Dm) + lane + 64 * j) = __builtin_convertvector(v[r][j], h16x4);
                    if (XH) *(unsigned long long*)(XH + ((size_t)(col >> 4) * 1024 + (m >> 4)) * 384 + 16 * (m & 15) + (col & 15)) = pv;
                }
            }
        }
    }
}
__device__ __forceinline__ void final_norm(const bf16* xr_, float* outp, const float* gvec, int gw, int ngw, int lane) {
    for (int m0 = gw; m0 < Mtok; m0 += 4 * ngw) {
        f32x4 v[4][4]; float s[4];
#pragma unroll
        for (int r = 0; r < 4; ++r) {
            const int m = m0 + r * ngw; const size_t ro = (size_t)(m < Mtok ? m : m0) * Dm;
#pragma unroll
            for (int j = 0; j < 4; ++j) v[r][j] = __builtin_convertvector(*((const h16x4*)(xr_ + ro) + lane + 64 * j), f32x4);
        }
#pragma unroll
        for (int r = 0; r < 4; ++r) {
            float a = 0.f;
#pragma unroll
            for (int j = 0; j < 4; ++j) a += (v[r][j][0] * v[r][j][0] + v[r][j][1] * v[r][j][1]) + (v[r][j][2] * v[r][j][2] + v[r][j][3] * v[r][j][3]);
            s[r] = 1.0f / sqrtf(wave_sum(a, lane) * (1.0f / Dm) + 1e-6f);
        }
#pragma unroll
        for (int j = 0; j < 4; ++j) {
            const f32x4 g = *(const f32x4*)(gvec + 4 * lane + 256 * j);
#pragma unroll
            for (int r = 0; r < 4; ++r) { const int m = m0 + r * ngw; if (m < Mtok) __builtin_nontemporal_store(v[r][j] * s[r] * g, (f32x4*)(outp + (size_t)m * Dm) + lane + 64 * j); }
        }
    }
}

__device__ __forceinline__ void prologue(KP P, LAS unsigned char* lds, int bid, int G, int tid, int w, int lane) {
    float* mods = (float*)(P->ws + WS_MODS);
    LAS float* red = (LAS float*)lds;
    for (int it = bid; it < 72; it += G) {
        const int l = it / 36, cb = it % 36;
        f32x4 a0 = {0.f, 0.f, 0.f, 0.f}, a1 = {0.f, 0.f, 0.f, 0.f};
        const float* wp = P->ada_w + ((size_t)l * 1024 + 128 * w) * 9216 + 256 * cb + 4 * lane;
#pragma unroll 16
        for (int kk = 0; kk < 128; ++kk) {
            const f32x4 wv = __builtin_nontemporal_load((const f32x4*)(wp + (size_t)kk * 9216));
            const float c0 = P->c[128 * w + kk], c1 = P->c[1024 + 128 * w + kk];
            const float s0 = c0 / (1.f + __expf(-c0)), s1 = c1 / (1.f + __expf(-c1));
            a0 += wv * s0; a1 += wv * s1;
        }
#pragma unroll
        for (int i = 0; i < 4; ++i) { red[(w * 2 + 0) * 256 + 4 * lane + i] = a0[i]; red[(w * 2 + 1) * 256 + 4 * lane + i] = a1[i]; }
        __syncthreads();
        { const int b = tid >> 8, col = tid & 255; float s = 0.f;
#pragma unroll
          for (int ww = 0; ww < 8; ++ww) s += red[(ww * 2 + b) * 256 + col];
          mods[(size_t)(l * 2 + b) * 9216 + 256 * cb + col] = s + P->ada_b[l * 9216 + 256 * cb + col]; }
        __syncthreads();
    }
    if (G > 144 && bid < 72) return;
    const int gt = (G > 144 ? bid - 72 : bid) * NTHR + tid, ngt = (G > 144 ? G - 72 : G) * NTHR;
    float* rot = (float*)(P->ws + WS_ROT);
    for (int e = gt; e < Mtok * 128; e += ngt) {
        const int m = e >> 7, d = e & 127;
        double invf = 1.0, bs = 0.9305720409296990;
#pragma unroll
        for (int q = 0; q < 7; ++q) { if ((d >> q) & 1) invf *= bs; bs *= bs; }
        const double a = (double)P->pos[m] * invf;
        const double kq = __builtin_rint(a * 0.15915494309189535);
        const float fr_ = (float)__builtin_fma(a, 0.15915494309189535, -kq);
        *(f32x2*)(rot + (size_t)e * 2) = (f32x2){__builtin_amdgcn_cosf(fr_), __builtin_amdgcn_sinf(fr_)};
    }
    f32x2* apw = (f32x2*)(P->ws + WS_APW); f32x2* epw = (f32x2*)(P->ws + WS_EPW);
    for (int e = gt; e < 64 * 64 * 17; e += ngt) {
        const int t = e % 17, gp = e / 17, g = gp >> 6;
        const float dt = __expf(P->log_dt[g]);
        const float are = P->a_re[gp], aim = P->a_im[gp];
        const float mg = __expf((float)t * dt * are);
        const double an = (double)t * (double)dt * (double)aim * 0.15915494309189535;
        const float fa = (float)(an - __builtin_rint(an));
        const float pr = mg * __builtin_amdgcn_cosf(fa), pi = mg * __builtin_amdgcn_sinf(fa);
        apw[e] = (f32x2){pr, pi};
        if (t < 16) {
            const float xx = dt * are;
            const float em1 = xx * (1.f + xx * (0.5f + xx * (0.16666667f + xx * (0.041666668f + xx * 0.0083333338f))));
            const double a1 = (double)dt * (double)aim * 0.15915494309189535;
            const float f1 = (float)(a1 - __builtin_rint(a1)); const double a2 = 0.5 * a1; const float f2 = (float)(a2 - __builtin_rint(a2));
            const float c1 = __builtin_amdgcn_cosf(f1), s1 = __builtin_amdgcn_sinf(f1), sh = __builtin_amdgcn_sinf(f2);
            const float br = em1 * c1 - 2.f * sh * sh, bi = (1.f + em1) * s1;
            const float den = are * are + aim * aim;
            const float wr = (br * are + bi * aim) / den, wi = (bi * are - br * aim) / den;
            epw[gp * 16 + t] = (f32x2){pr * wr - pi * wi, pr * wi + pi * wr};
        }
    }
}

__device__ __forceinline__ void s5_build(KP P, int gt, int ngt) {
    const f32x2* apw = (const f32x2*)(P->ws + WS_APW); const f32x2* epw = (const f32x2*)(P->ws + WS_EPW);
    bf16* TC = (bf16*)(P->ws + WS_TC); bf16* SP = (bf16*)(P->ws + WS_SP);
    for (int e = gt; e < 64 * 16 * 16 * 16; e += ngt) {
        const int kp = e & 15, k = (e >> 4) & 15, d = (e >> 8) & 15, g = e >> 12;
        float acc = 0.f;
        for (int p = 0; p < 64; ++p) {
            const f32x2 E = epw[(g * 64 + p) * 16 + d];
            const float br = P->b_re[((size_t)g * 64 + p) * 16 + kp], bi = P->b_im[((size_t)g * 64 + p) * 16 + kp];
            const float zr = E.x * br - E.y * bi, zi = E.x * bi + E.y * br;
            const float cr = P->c_re[((size_t)g * 16 + k) * 64 + p], ci = P->c_im[((size_t)g * 16 + k) * 64 + p];
            acc += cr * zr - ci * zi;
        }
        const bf16 v = (bf16)f2bf(acc);
        bf16* tg = TC + (size_t)g * 256 * 384;
        for (int j = 0; j + d < 16; ++j) { const int i = j + d; tg[(16 * i + k) * 384 + 16 * j + kp] = v; }
        if (d >= 1) for (int i = 0; i + d < 16; ++i) { const int j = i + d; tg[(16 * i + k) * 384 + 16 * j + kp] = 0; }
    }
    for (int e = gt; e < 64 * 64 * 16 * 16; e += ngt) {
        const int kp = e & 15, j = (e >> 4) & 15, p = (e >> 8) & 63, g = e >> 14;
        const f32x2 E = epw[(g * 64 + p) * 16 + (15 - j)];
        const float br = P->b_re[((size_t)g * 64 + p) * 16 + kp], bi = P->b_im[((size_t)g * 64 + p) * 16 + kp];
        bf16* sg = SP + (size_t)g * 256 * 384;
        sg[(2 * p) * 384 + 16 * j + kp] = (bf16)f2bf(E.x * br - E.y * bi);
        sg[(2 * p + 1) * 384 + 16 * j + kp] = (bf16)f2bf(E.x * bi + E.y * br);
    }
    for (int e = gt; e < 64 * 256 * 192; e += ngt) {
        const int g = e / (256 * 192), r = (e / 192) & 255, cp = e % 192;
        unsigned* sg = (unsigned*)(SP + (size_t)g * 256 * 384 + (size_t)r * 384);
        if (r >= 128 || cp >= 128) sg[cp] = 0u;
    }
    for (int e = gt; e < 64 * 16 * 16 * 64; e += ngt) {
        const int p = e & 63, k = (e >> 6) & 15, i = (e >> 10) & 15, g = e >> 14;
        const f32x2 A = apw[(g * 64 + p) * 17 + i + 1];
        const float cr = P->c_re[((size_t)g * 16 + k) * 64 + p], ci = P->c_im[((size_t)g * 16 + k) * 64 + p];
        const float wr = cr * A.x - ci * A.y, wi = cr * A.y + ci * A.x;
        *(unsigned*)(TC + (size_t)g * 256 * 384 + (16 * i + k) * 384 + 256 + 2 * p) = pk2(wr, -wi);
    }
}

#define MFMA16(a, b, c) __builtin_amdgcn_mfma_f32_16x16x32_bf16((a), (b), (c), 0, 0, 0)

__device__ __forceinline__ void s5b_phase(const float* Sloc, const f32x2* apw, bf16* XH, LAS unsigned char* lds, int bid, int G, int w, int lane) {
    LAS f32x2* E = (LAS f32x2*)lds;
    for (int u = bid; u < 128; u += G) {
        const int b = u >> 6, g = u & 63, p = lane;
        const f32x2 A16 = apw[(g * 64 + p) * 17 + 16];
        const float* sp = Sloc + ((size_t)(b * 512 + 64 * w) * 64 + g) * 128 + 2 * p;
        bf16* hp = XH + ((size_t)g * 1024 + b * 512 + 64 * w) * 384 + 256 + 2 * p;
        float er = 0.f, ei = 0.f;
#pragma unroll 1
        for (int hf = 0; hf < 2; ++hf) {
            f32x2 sv[32];
#pragma unroll
            for (int q = 0; q < 32; ++q) sv[q] = *(const f32x2*)(sp + (size_t)(32 * hf + q) * 8192);
#pragma unroll
            for (int q = 0; q < 32; ++q) { const float nr = A16.x * er - A16.y * ei + sv[q].x, ni = A16.x * ei + A16.y * er + sv[q].y; er = nr; ei = ni; }
        }
        E[w * 64 + p] = (f32x2){er, ei};
        float pr = A16.x, pi = A16.y;
#pragma unroll
        for (int q = 0; q < 6; ++q) { const float nr = pr * pr - pi * pi, ni = 2.f * pr * pi; pr = nr; pi = ni; }
        __syncthreads();
        float hr = 0.f, hi = 0.f;
        for (int k = 0; k < w; ++k) { const f32x2 e = E[k * 64 + p]; const float nr = pr * hr - pi * hi + e.x, ni = pr * hi + pi * hr + e.y; hr = nr; hi = ni; }
#pragma unroll 1
        for (int hf = 0; hf < 2; ++hf) {
            f32x2 sv[32];
#pragma unroll
            for (int q = 0; q < 32; ++q) sv[q] = *(const f32x2*)(sp + (size_t)(32 * hf + q) * 8192);
#pragma unroll
            for (int q = 0; q < 32; ++q) {
                *(unsigned*)(hp + (size_t)(32 * hf + q) * 384) = pk2(hr, hi);
                const float nr = A16.x * hr - A16.y * hi + sv[q].x, ni = A16.x * hi + A16.y * hr + sv[q].y; hr = nr; hi = ni;
            }
        }
        __syncthreads();
    }
}
__device__ __forceinline__ void r1_phase(const bf16* KD, const bf16* VT, bf16* KV, LAS unsigned char* lds, int bid, int G, int w, int lane_) {
    for (int u = bid; u < 256; u += G) {
        int lane = lane_; asm volatile("" : "+v"(lane));
        const int fr = lane & 15, fq = lane >> 4;
        const int h = u >> 6, n = u & 63;
        const char* kdu = (const char*)(KD + ((size_t)(8 * n) * 32 + 8 * h) * 512);
        const char* vtu = (const char*)(VT + ((size_t)(32 * h) * 256 + 4 * n) * 512);
#pragma unroll
        for (int q = 0; q < 8; ++q)
            __builtin_amdgcn_global_load_lds((const unsigned*)(kdu + (size_t)(w * 32 + q) * 1024 + lane * 16), (LAS unsigned*)(lds + (8 * w + q) * 1024), 16, 0, 0);
#define R1_DMA(p, bufoff) do { _Pragma("unroll") for (int q_ = 0; q_ < 4; ++q_) \
        __builtin_amdgcn_global_load_lds((const unsigned*)(vtu + (size_t)(8 * (p) + w) * 262144 + q_ * 1024 + lane * 16), (LAS unsigned*)(lds + (bufoff) + (4 * w + q_) * 1024), 16, 0, 0); } while (0)
        R1_DMA(0, 65536);
        asm volatile("s_waitcnt vmcnt(0)" ::: "memory");
        __syncthreads();
        bf16x8 af[2][4];
#pragma unroll
        for (int rbl = 0; rbl < 2; ++rbl)
#pragma unroll
            for (int ks = 0; ks < 4; ++ks) {
                const LAS unsigned short* base = (const LAS unsigned short*)(lds + ((2 * ks + (fq >> 1)) * 8 + w) * 1024) + ((2 * rbl + (fr >> 3)) * 16 + 8 * (fq & 1)) * 8 + (fr & 7);
                bf16x8 v;
#pragma unroll
                for (int jj = 0; jj < 8; ++jj) v[jj] = (short)base[jj * 8];
                af[rbl][ks] = v;
            }
#pragma unroll 1
        for (int p = 0; p < 4; ++p) {
            LAS unsigned char* buf = lds + 65536 + (p & 1) * 32768;
            if (p + 1 < 4) R1_DMA(p + 1, 65536 + ((p + 1) & 1) * 32768);
            f32x4 acc[2][8];
#pragma unroll
            for (int rbl = 0; rbl < 2; ++rbl)
#pragma unroll
                for (int cb = 0; cb < 8; ++cb) acc[rbl][cb] = (f32x4){0.f, 0.f, 0.f, 0.f};
#pragma unroll
            for (int cb = 0; cb < 8; ++cb)
#pragma unroll
                for (int ks = 0; ks < 4; ++ks) {
                    const bf16x8 vf = *(const LAS bf16x8*)(buf + (cb * 4 + ks) * 1024 + lane * 16);
                    acc[0][cb] = MFMA16(af[0][ks], vf, acc[0][cb]); acc[1][cb] = MFMA16(af[1][ks], vf, acc[1][cb]);
                }
#pragma unroll
            for (int rbl = 0; rbl < 2; ++rbl)
#pragma unroll
                for (int cb = 0; cb < 8; ++cb) {
                    const f32x4 a = acc[rbl][cb];
                    *(u32x2*)(KV + (size_t)u * 131072 + ((8 * p + cb) * 8 + w) * 512 + ((2 * rbl + (fq >> 1)) * 16 + fr) * 8 + 4 * (fq & 1)) = (u32x2){pk2(a[0], a[1]), pk2(a[2], a[3])};
                }
            asm volatile("s_waitcnt vmcnt(0)" ::: "memory");
            __syncthreads();
        }
    }
}
__device__ __forceinline__ void r2_phase(bf16* KV, int gt, int ngt) {
    for (int it = gt; it < 131072; it += ngt) {
        const int h = it >> 15, rem = it & 32767;
        const float gC = exp2f(128.0f * log2f(1.0f - exp2f(-5.0f - (float)h)));
        float s0 = 0.f, s1 = 0.f, s2 = 0.f, s3 = 0.f;
        bf16* base = KV + (size_t)h * 64 * 131072 + (size_t)rem * 4;
        for (int n0 = 0; n0 < 64; n0 += 8) {
            u32x2 kv[8];
#pragma unroll
            for (int q = 0; q < 8; ++q) kv[q] = *(const u32x2*)(base + (size_t)(n0 + q) * 131072);
#pragma unroll
            for (int q = 0; q < 8; ++q) {
                *(u32x2*)(base + (size_t)(n0 + q) * 131072) = (u32x2){pk2(s0, s1), pk2(s2, s3)};
                s0 = s0 * gC + __builtin_bit_cast(float, kv[q].x << 16); s1 = s1 * gC + __builtin_bit_cast(float, kv[q].x & 0xffff0000u);
                s2 = s2 * gC + __builtin_bit_cast(float, kv[q].y << 16); s3 = s3 * gC + __builtin_bit_cast(float, kv[q].y & 0xffff0000u);
            }
        }
    }
}
__device__ __forceinline__ const char* r3_stage_src(int s, const char* kb, const char* st, const char* vt, int c) {
    const int slot = c >> 6, lp = (c & 63) * 16;
    if (s < 2) return kb + (size_t)((4 * s + (slot >> 3)) * 32 + (slot & 7)) * 1024 + lp;
    if (s < 10) return st + (size_t)(s - 2) * 32768 + (size_t)c * 16;
    return vt + (size_t)slot * 262144 + (size_t)(s - 10) * 1024 + lp;
}
__device__ __forceinline__ void r3_phase(const bf16* Q, const bf16* Kb, const bf16* VT, const bf16* ST, bf16* Gb, LAS unsigned char* lds, int bid, int G, int tid_, int w, int lane_) {
    LAS bf16* sw = (LAS bf16*)(lds + 65536 + w * 4352);
    LAS bf16* ow = (LAS bf16*)(lds + w * 8448);
    for (int u = bid; u < 256; u += G) {
        int tid = tid_, lane = lane_; asm volatile("" : "+v"(tid), "+v"(lane));
        const int fr = lane & 15, fq = lane >> 4;
        const int h = u >> 6, n = u & 63;
        const float lg = log2f(1.0f - exp2f(-5.0f - (float)h));
        const char* kbu = (const char*)(Kb + ((size_t)(8 * n) * 32 + 8 * h) * 512);
        const char* stu = (const char*)(ST + (size_t)u * 131072);
        const char* vtu = (const char*)(VT + ((size_t)(32 * h) * 256 + 4 * n) * 512);
        bf16x8 qf[8];
        { const char* qtu = (const char*)(Q + ((size_t)(8 * n + w) * 32 + 8 * h) * 512);
#pragma unroll
          for (int ks = 0; ks < 8; ++ks) qf[ks] = *(const bf16x8*)(qtu + ks * 1024 + lane * 16); }
#define R3_DMA(sg, bufoff) do { _Pragma("unroll") for (int q_ = 0; q_ < 4; ++q_) \
        __builtin_amdgcn_global_load_lds((const unsigned*)r3_stage_src((sg), kbu, stu, vtu, (4 * w + q_) * 64 + lane), (LAS unsigned*)(lds + (bufoff) + (4 * w + q_) * 1024), 16, 0, 0); } while (0)
        R3_DMA(0, 0);
        asm volatile("s_waitcnt vmcnt(0)" ::: "memory");
        __syncthreads();
        const int jbmax = w | 1, ksmax = w >> 1;
        f32x4 as[8];
#pragma unroll
        for (int jb = 0; jb < 8; ++jb) as[jb] = (f32x4){0.f, 0.f, 0.f, 0.f};
        f32x4 o[32];
#pragma unroll
        for (int s = 0; s < 14; ++s) {
            LAS unsigned char* buf = lds + (s & 1) * 32768;
            if (s + 1 < 14) R3_DMA(s + 1, ((s + 1) & 1) * 32768);
            if (s < 2) {
#pragma unroll
                for (int jl = 0; jl < 4; ++jl)
                    if (4 * s + jl <= jbmax) {
#pragma unroll
                        for (int ks = 0; ks < 8; ++ks) { const bf16x8 kf = *(const LAS bf16x8*)(buf + (jl * 8 + ks) * 1024 + lane * 16); as[4 * s + jl] = MFMA16(qf[ks], kf, as[4 * s + jl]); }
                        asm volatile("" ::: "memory");
                    }
                if (s == 1) {
#pragma unroll
                    for (int jb = 0; jb < 8; ++jb)
                        if (jb <= jbmax) {
#pragma unroll
                            for (int ii = 0; ii < 4; ++ii) {
                                const int i = 16 * w + 4 * fq + ii, j = 16 * jb + fr;
                                const float v = (i >= j) ? as[jb][ii] * __builtin_amdgcn_exp2f(lg * (float)(i - 127)) : 0.f;
                                sw[(4 * fq + ii) * 136 + j] = (bf16)f2bf(v);
                            }
                        }
                }
            } else if (s < 10) {
                if (s == 2) {
#pragma unroll
                    for (int eb = 0; eb < 32; ++eb) o[eb] = (f32x4){0.f, 0.f, 0.f, 0.f};
                }
#pragma unroll
                for (int el = 0; el < 4; ++el)
#pragma unroll
                    for (int ks = 0; ks < 8; ++ks) { const bf16x8 sf = *(const LAS bf16x8*)(buf + (el * 8 + ks) * 1024 + lane * 16); o[4 * (s - 2) + el] = MFMA16(qf[ks], sf, o[4 * (s - 2) + el]); if ((ks & 3) == 3) asm volatile("" ::: "memory"); }
                if (s == 9) {
                    float qd[4];
#pragma unroll
                    for (int ii = 0; ii < 4; ++ii) qd[ii] = __builtin_amdgcn_exp2f(lg * (float)(16 * w + 4 * fq + ii + 1));
#pragma unroll
                    for (int eb = 0; eb < 32; ++eb)
#pragma unroll
                        for (int ii = 0; ii < 4; ++ii) o[eb][ii] *= qd[ii];
                }
            } else {
                if (s - 10 <= ksmax) {
                    const bf16x8 af = *(const LAS bf16x8*)(sw + fr * 136 + 32 * (s - 10) + 8 * fq);
#pragma unroll
                    for (int eb = 0; eb < 32; ++eb) { const bf16x8 vf = *(const LAS bf16x8*)(buf + eb * 1024 + lane * 16); o[eb] = MFMA16(af, vf, o[eb]); if ((eb & 7) == 7) asm volatile("" ::: "memory"); }
                }
            }
            asm volatile("s_waitcnt vmcnt(0)" ::: "memory");
            __syncthreads();
        }
        float mean[4], rstd[4];
#pragma unroll
        for (int ii = 0; ii < 4; ++ii) {
            float sm = 0.f;
#pragma unroll
            for (int eb = 0; eb < 32; ++eb) sm += o[eb][ii];
            sm += shx(sm, 1, lane); sm += shx(sm, 2, lane); sm += shx(sm, 4, lane); sm += shx(sm, 8, lane);
            const float mu = sm * (1.0f / 512.0f); float q = 0.f;
#pragma unroll
            for (int eb = 0; eb < 32; ++eb) { const float dd = o[eb][ii] - mu; q += dd * dd; }
            q += shx(q, 1, lane); q += shx(q, 2, lane); q += shx(q, 4, lane); q += shx(q, 8, lane);
            mean[ii] = mu; rstd[ii] = __builtin_amdgcn_rsqf(q * (1.0f / 512.0f) + 1e-5f);
        }
#pragma unroll
        for (int hf = 0; hf < 2; ++hf) {
#pragma unroll
            for (int e2 = 0; e2 < 16; ++e2)
#pragma unroll
                for (int ii = 0; ii < 4; ++ii) { ow[(4 * fq + ii) * 264 + 16 * e2 + fr] = (bf16)f2bf((o[16 * hf + e2][ii] - mean[ii]) * rstd[ii]); if (ii == 3 && (e2 & 3) == 3) asm volatile("" ::: "memory"); }
            __syncthreads();
#pragma unroll 1
            for (int qh = 0; qh < 2; ++qh) {
                u32x4 gq[4];
#pragma unroll
                for (int q4 = 0; q4 < 4; ++q4) { const int c = lane + 64 * (4 * qh + q4); gq[q4] = *(const u32x4*)(Gb + (size_t)(128 * n + 16 * w + (c >> 5)) * 2048 + 512 * h + 256 * hf + 8 * (c & 31)); }
#pragma unroll
                for (int q4 = 0; q4 < 4; ++q4) {
                    const int c = lane + 64 * (4 * qh + q4), row = c >> 5, c8 = c & 31;
                    const u32x4 ov = *(const LAS u32x4*)(ow + row * 264 + 8 * c8);
                    bf16* gp = Gb + (size_t)(128 * n + 16 * w + row) * 2048 + 512 * h + 256 * hf + 8 * c8;
                    const u32x4 gv = gq[q4];
                    u32x4 r;
#pragma unroll
                    for (int t = 0; t < 4; ++t) {
                        const float a0 = __builtin_bit_cast(float, ov[t] << 16) * __builtin_bit_cast(float, gv[t] << 16);
                        const float a1 = __builtin_bit_cast(float, ov[t] & 0xffff0000u) * __builtin_bit_cast(float, gv[t] & 0xffff0000u);
                        r[t] = pk2(a0, a1);
                    }
                    *(u32x4*)gp = r;
                }
            }
            __syncthreads();
        }
    }
}

#define XB_TMO      128
#define XB_XCNT(j)  (256  + 64 * (j))
#define XB_XSUB(j)  (1280 + 64 * (j))
#define XB_XGEN(j)  (2304 + 64 * (j))
#define XB_TOP      3328
#define XB_TOPGEN   3392
#define XCD_BAR_WORDS 3456
#define XB_SPIN_CAP (1u << 18)

__device__ __forceinline__ unsigned xb_ld(unsigned* p)              { return __hip_atomic_load(p, __ATOMIC_RELAXED, __HIP_MEMORY_SCOPE_AGENT); }
__device__ __forceinline__ unsigned xb_add(unsigned* p, unsigned v) { return __hip_atomic_fetch_add(p, v, __ATOMIC_RELAXED, __HIP_MEMORY_SCOPE_AGENT); }
__device__ __forceinline__ unsigned xb_xcc_id() { return (unsigned)__builtin_amdgcn_s_getreg((3 << 11) | 20) & 0xFu; }
#define XB_SPIN(cond, bar) do { unsigned _sp = 0; while (cond) { __builtin_amdgcn_s_sleep(1); \
    if ((++_sp & 255u) == 0u) { if (xb_ld(&(bar)[XB_TMO])) break; if (_sp > XB_SPIN_CAP) { atomicAdd(&(bar)[XB_TMO], 1u); break; } } } } while (0)

struct XcdBarrier {
    unsigned* bar; unsigned x;
    volatile LAS unsigned* st;
};

__device__ __forceinline__ XcdBarrier xcd_barrier_post(unsigned* bar, volatile LAS unsigned* st) {
    XcdBarrier b; b.bar = bar; b.x = xb_xcc_id(); b.st = st;
    if (threadIdx.x == 0) (void)xb_add(&bar[XB_XCNT(b.x)], 1u);
    return b;
}
__device__ __forceinline__ void xcd_barrier_complete(unsigned* bar, unsigned x, unsigned& nloc, unsigned& nx) {
    const unsigned G = gridDim.x * gridDim.y * gridDim.z;
    unsigned sum, cnt, mine, sp = 0u;
    for (;;) {
        sum = 0u; cnt = 0u; mine = 0u;
#pragma unroll
        for (unsigned j = 0; j < 16; ++j) { const unsigned c = xb_ld(&bar[XB_XCNT(j)]); sum += c; cnt += (c > 0u) ? 1u : 0u; mine = (j == x) ? c : mine; }
        if (sum == G) break;
        __builtin_amdgcn_s_sleep(1);
        if ((++sp & 255u) == 0u) { if (xb_ld(&bar[XB_TMO])) break; if (sp > XB_SPIN_CAP) { atomicAdd(&bar[XB_TMO], 1u); break; } }
    }
    nloc = mine > 0u ? mine : 1u; nx = cnt > 0u ? cnt : 1u;
}

__device__ __forceinline__ void xcd_barrier(const XcdBarrier& b) {
    asm volatile("s_waitcnt vmcnt(0)" ::: "memory");
    __syncthreads();
    if (threadIdx.x == 0) {
        unsigned* bar = b.bar;
        __builtin_amdgcn_s_waitcnt(0);
        unsigned nloc = b.st[0], nx = b.st[1];
        if (nloc == 0u) { xcd_barrier_complete(bar, b.x, nloc, nx); b.st[0] = nloc; b.st[1] = nx; }
        const unsigned old = xb_add(&bar[XB_XSUB(b.x)], 1u);
        const unsigned gen = old / nloc;
        if (old + 1u == (gen + 1u) * nloc) {
            __builtin_amdgcn_fence(__ATOMIC_RELEASE, "agent");
            asm volatile("s_waitcnt vmcnt(0)" ::: "memory");
            const unsigned og = xb_add(&bar[XB_TOP], 1u);
            const unsigned tg = og / nx;
            if (og + 1u == (tg + 1u) * nx) xb_add(&bar[XB_TOPGEN], 1u);
            else XB_SPIN(xb_ld(&bar[XB_TOPGEN]) == tg, bar);
            __builtin_amdgcn_fence(__ATOMIC_ACQUIRE, "agent");
            xb_add(&bar[XB_XGEN(b.x)], 1u);
            asm volatile("s_waitcnt vmcnt(0)" ::: "memory");
        } else {
            XB_SPIN(xb_ld(&bar[XB_XGEN(b.x)]) == gen, bar);
            __builtin_amdgcn_fence(__ATOMIC_ACQUIRE, "agent");
            asm volatile("s_waitcnt vmcnt(0)" ::: "memory");
        }
    }
    __syncthreads();
}

__global__ void __launch_bounds__(NTHR, 2) fwd_megakernel(Params P) {
    extern __shared__ __attribute__((aligned(16))) unsigned char lds_raw[];
    LAS unsigned char* lds0 = (LAS unsigned char*)lds_raw;
    cg::grid_group grid = cg::this_grid();
    { volatile LAS unsigned* stw = (volatile LAS unsigned*)(lds0 + 131072 + 256); if (threadIdx.x < 4) stw[threadIdx.x] = 0u; }
    __syncthreads();
    (void)xcd_barrier_post((unsigned*)(P.ws + WS_BAR), (volatile LAS unsigned*)(lds0 + 131072 + 256));
    const int nph = P.nph;
    {
        KP Q0 = (KP)__builtin_amdgcn_kernarg_segment_ptr(); asm volatile("" : "+s"(Q0));
        int tid0 = threadIdx.x; asm volatile("" : "+v"(tid0));
        prologue(Q0, lds0, (int)blockIdx.x, (int)gridDim.x, tid0, __builtin_amdgcn_readfirstlane(tid0 >> 6), tid0 & 63);
        XcdBarrier xb; xb.bar = (unsigned*)(Q0->ws + WS_BAR); xb.x = xb_xcc_id(); xb.st = (volatile LAS unsigned*)(lds0 + 131072 + 256); xcd_barrier(xb);
    }
    for (int ph = 1; ph < nph; ++ph) {
        KP Q = (KP)__builtin_amdgcn_kernarg_segment_ptr(); asm volatile("" : "+s"(Q));
        unsigned char* ws = Q->ws; asm volatile("" : "+s"(ws));
        int bid = blockIdx.x, G = gridDim.x; asm volatile("" : "+s"(bid), "+s"(G));
        LAS unsigned char* lds = lds0; asm volatile("" : "+s"(lds));
#define TLW int tid = threadIdx.x; asm volatile("" : "+v"(tid)); const int lane = tid & 63, w = __builtin_amdgcn_readfirstlane(tid >> 6); (void)lane; (void)w;
#define gw (bid * NWAVES + w)
#define ngw (G * NWAVES)
#define gt (bid * NTHR + tid)
#define ngt (G * NTHR)
#define mods ((float*)(ws + WS_MODS))
#define XN ((bf16*)(ws + WS_XN))
#define XR ((bf16*)Q->out)
#define XF ((bf16*)(ws + WS_BIG + 100 * MiB))
#define scr ((LAS float*)(lds + w * 8704))
#define modl (mods + (size_t)l * 2 * 9216)
        const int kind = Q->ph[ph][0], l = Q->ph[ph][1], sub = Q->ph[ph][2], b = Q->ph[ph][3];
        switch (kind) {
        case K_ROW: { TLW
            if (sub != 1) {
                const int fi = l * 2 + (sub >> 1);
                conv_job(Q->ffn_w_in + (size_t)fi * 1024 * 5632, 1024, 5632, (bf16*)(ws + WS_WB), 1, 2816, scr, gw, ngw, lane);
            } else if (l == 0) {
                conv_job(Q->ret_w_in, 1024, 6144, (bf16*)(ws + WS_WB), 2, 0, scr, gw, ngw, lane);
                conv_job(Q->ret_w_out, 2048, 1024, (bf16*)(ws + WS_WB2), 0, 0, scr, gw, ngw, lane);
            } else {
                conv_job(Q->w_glu, 1024, 2048, (bf16*)(ws + WS_WB), 1, 1024, scr, gw, ngw, lane);
                s5_build(Q, gt, ngt);
            }
            const void* xin = (l == 0 && sub == 0) ? (const void*)Q->x : (const void*)XR; const int in_f32 = (l == 0 && sub == 0) ? 1 : 0;
            row_pass(xin, in_f32, Q->norm_g + (size_t)(l * 3 + sub) * 1024, modl + 3072 * sub, modl + 3072 * sub + 1024, XN, (l == 1 && sub == 1) ? (bf16*)(ws + WS_XH) : (bf16*)nullptr, (l == 0 && sub == 0) ? XR : (bf16*)nullptr, gw, ngw, lane);
        } break;
        case K_FFN_IN: {
            pg8::Gemm g{XN, (const bf16*)(ws + WS_WB), Mtok, 2 * FF, Dm}; pg8::StaticOrder S; S.init(Mtok, 2 * FF, G, bid);
            pg8::EpiSwiGLU E{(bf16*)(ws + WS_H), FF};
            pg8::gemm_phase<pg8::EpiSwiGLU, pg8::StaticOrder, true, true>(lds, g, S, E);
            { TLW
              const int fi = l * 2 + (sub >> 1);
              if (G == 256) { if (bid >= 128) conv_job(Q->ffn_w_out + (size_t)fi * 2816 * 1024, 2816, 1024, (bf16*)(ws + WS_WB2), 0, 0, scr, (bid - 128) * NWAVES + w, 128 * NWAVES, lane); }
              else conv_job(Q->ffn_w_out + (size_t)fi * 2816 * 1024, 2816, 1024, (bf16*)(ws + WS_WB2), 0, 0, scr, gw, ngw, lane); }
        } break;
        case K_FFN_OUT: case K_RETOUT: {
            const bool isf = kind == K_FFN_OUT;
            pg8::Gemm g{isf ? (const bf16*)(ws + WS_H) : (const bf16*)(ws + WS_G), (const bf16*)(ws + WS_WB2), Mtok, Dm, isf ? FF : 2048}; pg8::StaticOrder S; S.init(Mtok, Dm, G, bid);
            pg8::EpiResid E{XR, (isf && l == 1 && sub == 2) ? XF : XR, modl + 3072 * sub + 2048, isf ? 0.5f : 1.0f};
            pg8::gemm_phase<pg8::EpiResid, pg8::StaticOrder, true, true>(lds, g, S, E);
        } break;
        case K_G3: {
            const float* rot = (const float*)(ws + WS_ROT) + (size_t)b * Lseq * 256;
            { pg8::Gemm g{XN + (size_t)b * Lseq * Dm, (const bf16*)(ws + WS_WB), Lseq, 4096, Dm}; pg8::StaticOrder S; S.init(Lseq, 4096, G, bid);
              pg8::EpiRet3a E{(bf16*)(ws + WS_G) + (size_t)b * Lseq * 2048, (bf16*)(ws + WS_Q), (bf16*)(ws + WS_K), (bf16*)(ws + WS_KT), rot};
              pg8::gemm_phase<pg8::EpiRet3a, pg8::StaticOrder, true, true>(lds, g, S, E); }
            { pg8::Gemm g{(const bf16*)(ws + WS_WB) + (size_t)4096 * Dm, XN + (size_t)b * Lseq * Dm, 2048, Lseq, Dm}; pg8::StaticOrder S; S.init(2048, Lseq, G, bid);
              pg8::EpiRet3b E{(bf16*)(ws + WS_VT)};
              pg8::gemm_phase<pg8::EpiRet3b, pg8::StaticOrder, true, true>(lds, g, S, E); }
        } break;
        case K_R1: { TLW r1_phase((const bf16*)(ws + WS_KT), (const bf16*)(ws + WS_VT), (bf16*)(ws + WS_KV), lds, bid, G, w, lane); } break;
        case K_R2: { TLW r2_phase((bf16*)(ws + WS_KV), gt, ngt); } break;
        case K_R3: { TLW r3_phase((const bf16*)(ws + WS_Q), (const bf16*)(ws + WS_KT), (const bf16*)(ws + WS_VT), (const bf16*)(ws + WS_KV), (bf16*)(ws + WS_G) + (size_t)b * Lseq * 2048, lds, bid, G, tid, w, lane); } break;
        case K_S5A: {
            pg8::Gemm g{(const bf16*)(ws + WS_XH), (const bf16*)(ws + WS_SP), 65536, 256, 384}; pg8::S5Order S{G, bid};
            pg8::EpiS5A E{(float*)(ws + WS_SLOC)};
            pg8::gemm_phase<pg8::EpiS5A, pg8::S5Order, true, true>(lds, g, S, E);
        } break;
        case K_S5B: { TLW s5b_phase((const float*)(ws + WS_SLOC), (const f32x2*)(ws + WS_APW), (bf16*)(ws + WS_XH), lds, bid, G, w, lane); } break;
        case K_S5C: {
            pg8::Gemm g{(const bf16*)(ws + WS_XH), (const bf16*)(ws + WS_TC), 65536, 256, 384}; pg8::S5Order S{G, bid};
            pg8::EpiS5C E{XN, Q->s5_d, (bf16*)(ws + WS_YG)};
            pg8::gemm_phase<pg8::EpiS5C, pg8::S5Order, true, true>(lds, g, S, E);
        } break;
        case K_GLU: {
            pg8::Gemm g{(const bf16*)(ws + WS_YG), (const bf16*)(ws + WS_WB), Mtok, 2048, Dm}; pg8::StaticOrder S; S.init(Mtok, 2048, G, bid);
            pg8::EpiGLU E{XR, modl + 3072 + 2048};
            pg8::gemm_phase<pg8::EpiGLU, pg8::StaticOrder, true, true>(lds, g, S, E);
        } break;
        case K_FINAL: { TLW final_norm(XF, Q->out, Q->final_g, gw, ngw, lane); } break;
        default: break;
        }
        if (ph + 1 < nph) { if (nph > MAXPH) grid.sync();   else { XcdBarrier xb; xb.bar = (unsigned*)(ws + WS_BAR); xb.x = xb_xcc_id(); xb.st = (volatile LAS unsigned*)(lds + 131072 + 256); xcd_barrier(xb); } }
    }
}

#undef TLW
#undef gw
#undef ngw
#undef gt
#undef ngt
#undef mods
#undef XN
#undef XR
#undef XF
#undef scr
#undef modl
extern "C" void kernel_launch(void* const* d_in, const int* in_sizes, int n_in, void* d_out, int out_size, void* d_ws, size_t ws_size, hipStream_t stream) {
    static int grid = 0;
    if (grid == 0) {
        if (n_in != 20 || in_sizes[0] != Mtok * Dm || out_size != Mtok * Dm || ws_size < WS_END) {
            fprintf(stderr, "kernel_launch: unexpected problem (n_in %d, in0 %d, out %d, ws %zu, need %zu); nothing launched\n", n_in, n_in > 0 ? in_sizes[0] : -1, out_size, ws_size, (size_t)WS_END);
            grid = -1; return;
        }
        int dev = 0, cus = 0, per_cu = 0;
        hipGetDevice(&dev);
        hipDeviceGetAttribute(&cus, hipDeviceAttributeMultiprocessorCount, dev);
        hipFuncSetAttribute((const void*)fwd_megakernel, hipFuncAttributeMaxDynamicSharedMemorySize, LDS_BYTES);
        hipOccupancyMaxActiveBlocksPerMultiprocessor(&per_cu, (const void*)fwd_megakernel, NTHR, LDS_BYTES);
        if (per_cu < 1) { fprintf(stderr, "kernel_launch: occupancy query reports %d blocks per CU; nothing launched\n", per_cu); grid = -1; return; }
        grid = cus;
        fprintf(stderr, "kernel_launch: grid %d (per_cu %d), ws %zu\n", grid, per_cu, ws_size);
    }
    if (grid < 0) return;
    Params p{};
    p.x = (const float*)d_in[0]; p.c = (const float*)d_in[1]; p.pos = (const int*)d_in[2]; p.ada_w = (const float*)d_in[3]; p.ada_b = (const float*)d_in[4];
    p.norm_g = (const float*)d_in[5]; p.ffn_w_in = (const float*)d_in[6]; p.ffn_w_out = (const float*)d_in[7]; p.ret_w_in = (const float*)d_in[8]; p.ret_w_out = (const float*)d_in[9];
    p.a_re = (const float*)d_in[10]; p.a_im = (const float*)d_in[11]; p.b_re = (const float*)d_in[12]; p.b_im = (const float*)d_in[13]; p.c_re = (const float*)d_in[14]; p.c_im = (const float*)d_in[15];
    p.s5_d = (const float*)d_in[16]; p.log_dt = (const float*)d_in[17]; p.w_glu = (const float*)d_in[18]; p.final_g = (const float*)d_in[19];
    p.out = (float*)d_out; p.ws = (unsigned char*)d_ws;
    int n = 0;
    auto add = [&](int k, int l, int s, int b) { p.ph[n][0] = (unsigned char)k; p.ph[n][1] = (unsigned char)l; p.ph[n][2] = (unsigned char)s; p.ph[n][3] = (unsigned char)b; ++n; };
#ifndef EXP
#define EXP 0
#endif
    const int rPRO = (EXP == 1) ? 2 : 1, rROW = (EXP == 1) ? 2 : 1, rRET = (EXP == 2) ? 2 : 1, rS5 = (EXP == 3) ? 2 : 1, rFIN = (EXP == 4) ? 2 : 1;
    for (int r = 0; r < rPRO; ++r) add(K_PRO, 0, 0, 0);
    for (int l = 0; l < 2; ++l)
        for (int s = 0; s < 3; ++s) {
            for (int r = 0; r < rROW; ++r) add(K_ROW, l, s, 0);
            if (s != 1) { for (int r = 0; r < rFIN; ++r) add(K_FFN_IN, l, s, 0); add(K_FFN_OUT, l, s, 0); }
            else if (l == 0) { for (int b = 0; b < 2; ++b) for (int r = 0; r < rRET; ++r) { add(K_G3, 0, 1, b); add(K_R1, 0, 1, b); add(K_R2, 0, 1, b); add(K_R3, 0, 1, b); } add(K_RETOUT, 0, 1, 0); }
            else { for (int r = 0; r < rS5; ++r) add(K_S5A, 1, 1, 0); for (int r = 0; r < rS5; ++r) add(K_S5B, 1, 1, 0); for (int r = 0; r < rS5; ++r) add(K_S5C, 1, 1, 0); add(K_GLU, 1, 1, 0); }
        }
    add(K_FINAL, 0, 0, 0);
    p.nph = n;
    hipMemsetAsync((char*)d_ws + WS_BAR, 0, 16384, stream);
    void* args[] = {&p};
    hipError_t e = hipLaunchCooperativeKernel((const void*)fwd_megakernel, dim3(grid), dim3(NTHR), args, LDS_BYTES, stream);
    if (e != hipSuccess) fprintf(stderr, "kernel_launch: cooperative launch failed: %s (grid %d)\n", hipGetErrorString(e), grid);
}
```

```cpp
#include <hip/hip_runtime.h>
#include <hip/hip_cooperative_groups.h>
#include <cstdio>
#include <cstdint>
namespace cg = cooperative_groups;
namespace pg8 {
#define PG8_LAS __attribute__((address_space(3)))
typedef unsigned short bf16_t;
typedef short bf16x8 __attribute__((ext_vector_type(8)));
typedef float f32x4 __attribute__((ext_vector_type(4)));
typedef unsigned u32x4 __attribute__((ext_vector_type(4)));
constexpr int BM = 256, BK = 64, HALF = 128, HTB = HALF * BK * 2  , STAGE_BYTES = 8 * HTB, NXCD = 8, WGM = 8;

__host__ __device__ __forceinline__ int lds_byte(int r, int c) { const int st = (r >> 4) * 2 + (c >> 5), rr = r & 15, cc = c & 31, ob = rr * 64 + cc * 2; return st * 1024 + (ob ^ (((ob >> 9) & 1) << 5)); }
__host__ __device__ __forceinline__ void stage_rc(int b, int& R, int& C) { const int st = b / 1024, sb = b % 1024, swz = sb ^ (((sb >> 9) & 1) << 5); R = (st >> 1) * 16 + swz / 64; C = (st & 1) * 32 + (swz % 64) / 2; }
__host__ __device__ __forceinline__ int perm32(int rho) { const int n = rho >> 4, i = rho & 15; return 8 * (i >> 2) + 4 * n + (i & 3); }

struct Unit { int pm, pn; };
struct Gemm { const bf16_t* A; const bf16_t* Bt; int M, N, K; };

struct StaticOrder {
    int nM, nN, nwg, G, c;
    __host__ __device__ void init(int M, int N, int G_, int c_) { nM = M / BM; nN = N / BM; nwg = nM * nN; G = G_; c = c_; }
    __host__ __device__ bool next(int i, Unit& u) const {
        const long L = (long)i * G + c; if (L >= nwg) return false;
        int wgid = (int)L; { const int q = nwg / NXCD, r = nwg % NXCD, xcd = wgid % NXCD, off = wgid / NXCD; wgid = (xcd < r ? xcd * (q + 1) : r * (q + 1) + (xcd - r) * q) + off; }
        const int nig = WGM * nN, gid = wgid / nig, fm = gid * WGM, gsz = (nM - fm) < WGM ? (nM - fm) : WGM;
        u.pm = fm + ((wgid % nig) % gsz); u.pn = (wgid % nig) / gsz; return true;
    }
    __device__ __forceinline__ void a_ready(const Unit&) const {}
    __device__ __forceinline__ void done(const Unit&) const {}
};
__device__ __forceinline__ unsigned cvt_pk_bf16(float lo, float hi) { unsigned r; asm volatile("v_cvt_pk_bf16_f32 %0, %1, %2" : "=v"(r) : "v"(lo), "v"(hi)); return r; }
typedef float f32x2 __attribute__((ext_vector_type(2)));
typedef unsigned u32x2 __attribute__((ext_vector_type(2)));
typedef _Float16 h16x4 __attribute__((ext_vector_type(4)));
__device__ __forceinline__ float silu_f(float v) { return v * __builtin_amdgcn_rcpf(1.f + __expf(-v)); }
__device__ __forceinline__ float sigm_f(float v) { return __builtin_amdgcn_rcpf(1.f + __expf(-v)); }
__device__ __forceinline__ u32x4 pack8(f32x4 a, f32x4 b) { u32x4 w; w.x = cvt_pk_bf16(a[0], a[1]); w.y = cvt_pk_bf16(a[2], a[3]); w.z = cvt_pk_bf16(b[0], b[1]); w.w = cvt_pk_bf16(b[2], b[3]); return w; }

struct EpiSwiGLU {
    static constexpr bool PERM = true, AFTER_DRAIN = false;
    bf16_t* O; int ldc;
    __device__ __forceinline__ void operator()(const f32x4 (&acc)[2][2][4][2], const Unit& u, int wr, int wc, int fr, int fq) const {
        asm volatile("" : "+v"(fr), "+v"(fq));
        const int row0 = u.pm * BM + wr * 64 + fr, col0 = u.pn * HALF + wc * 32 + 8 * fq;
#pragma unroll
        for (int ai = 0; ai < 2; ++ai)
#pragma unroll
            for (int m = 0; m < 4; ++m) {
                bf16_t* rowp = O + (size_t)(row0 + ai * HALF + m * 16) * ldc + col0;
                f32x4 o0, o1;
#pragma unroll
                for (int i = 0; i < 4; ++i) { o0[i] = silu_f(acc[ai][0][m][0][i]) * acc[ai][1][m][0][i]; o1[i] = silu_f(acc[ai][0][m][1][i]) * acc[ai][1][m][1][i]; }
                *(u32x4*)rowp = pack8(o0, o1);
            }
    }
};
struct EpiResid {
    static constexpr bool PERM = false, AFTER_DRAIN = true;
    const bf16_t* base; bf16_t* out; const float* gate; float gs;
    __device__ __forceinline__ void fused(f32x4 (&acc)[2][2][4][2], const Unit& u, int wr, int wc, int fr, int fq, PG8_LAS unsigned char* lds, int wid, int lane) const {
        asm volatile("" : "+v"(fr), "+v"(fq), "+v"(lane));
        PG8_LAS float* T = (PG8_LAS float*)lds;
        const int b = u.pm >> 5;
        const f32x4 gv = *(const f32x4*)(gate + b * 9216 + u.pn * BM + 4 * lane) * gs;
        h16x4 bsr[4][8];
#pragma unroll
        for (int ps = 0; ps < 4; ++ps)
#pragma unroll
            for (int q = 0; q < 8; ++q) {
                const int rl = wid * 8 + q, actual = (ps >> 1) * HALF + 64 * (rl >> 5) + 16 * (2 * (ps & 1) + ((rl >> 4) & 1)) + (rl & 15);
                bsr[ps][q] = *(const h16x4*)(base + (size_t)(u.pm * BM + actual) * 1024 + u.pn * BM + 4 * lane);
            }
#pragma unroll
        for (int ai = 0; ai < 2; ++ai)
#pragma unroll
            for (int mh = 0; mh < 2; ++mh) {
#pragma unroll
                for (int mp = 0; mp < 2; ++mp)
#pragma unroll
                    for (int bj = 0; bj < 2; ++bj)
#pragma unroll
                        for (int n = 0; n < 2; ++n)
                            *(PG8_LAS f32x4*)(T + (wr * 32 + mp * 16 + fr) * 272 + bj * HALF + wc * 32 + n * 16 + 4 * fq) = acc[ai][bj][2 * mh + mp][n];
                __syncthreads();
#pragma unroll
                for (int q = 0; q < 8; ++q) {
                    const int rl = wid * 8 + q, actual = ai * HALF + 64 * (rl >> 5) + 16 * (2 * mh + ((rl >> 4) & 1)) + (rl & 15);
                    const size_t off = (size_t)(u.pm * BM + actual) * 1024 + u.pn * BM + 4 * lane;
                    const f32x4 bs = __builtin_convertvector(bsr[2 * ai + mh][q], f32x4);
                    const f32x4 o = bs + gv * *(const PG8_LAS f32x4*)(T + rl * 272 + 4 * lane);
                    *(h16x4*)(out + off) = __builtin_convertvector(o, h16x4);
                }
                __syncthreads();
            }
    }
};
struct EpiGLU {
    static constexpr bool PERM = true, AFTER_DRAIN = false;
    bf16_t* xr; const float* gate;
    __device__ __forceinline__ void operator()(const f32x4 (&acc)[2][2][4][2], const Unit& u, int wr, int wc, int fr, int fq) const {
        asm volatile("" : "+v"(fr), "+v"(fq));
        const int b = u.pm >> 5, col = u.pn * HALF + wc * 32 + 8 * fq;
        const f32x4 g0 = *(const f32x4*)(gate + b * 9216 + col), g1 = *(const f32x4*)(gate + b * 9216 + col + 4);
#pragma unroll
        for (int ai = 0; ai < 2; ++ai)
#pragma unroll
            for (int m = 0; m < 4; ++m) {
                const size_t off = (size_t)(u.pm * BM + ai * HALF + wr * 64 + m * 16 + fr) * 1024 + col;
                const f32x4 r0 = __builtin_convertvector(*(const h16x4*)(xr + off), f32x4), r1 = __builtin_convertvector(*(const h16x4*)(xr + off + 4), f32x4);
                f32x4 o0, o1;
#pragma unroll
                for (int t = 0; t < 4; ++t) {
                    o0[t] = r0[t] + g0[t] * (acc[ai][0][m][0][t] * sigm_f(acc[ai][1][m][0][t]));
                    o1[t] = r1[t] + g1[t] * (acc[ai][0][m][1][t] * sigm_f(acc[ai][1][m][1][t]));
                }
                *(h16x4*)(xr + off) = __builtin_convertvector(o0, h16x4); *(h16x4*)(xr + off + 4) = __builtin_convertvector(o1, h16x4);
            }
    }
};
struct EpiRet3a {
    static constexpr bool PERM = true, AFTER_DRAIN = false;
    bf16_t* G; bf16_t* Q; bf16_t* K; bf16_t* KD; const float* rot;
    __device__ __forceinline__ void operator()(const f32x4 (&acc)[2][2][4][2], const Unit& u, int wr, int wc, int fr, int fq) const {
        asm volatile("" : "+v"(fr), "+v"(fq));
        const int row0 = u.pm * BM + wr * 64 + fr;
        if (u.pn < 8) {
            const int col0 = u.pn * BM + wc * 32 + 8 * fq;
#pragma unroll
            for (int ai = 0; ai < 2; ++ai)
#pragma unroll
                for (int m = 0; m < 4; ++m)
#pragma unroll
                    for (int bj = 0; bj < 2; ++bj) {
                        f32x4 o0, o1;
#pragma unroll
                        for (int i = 0; i < 4; ++i) { o0[i] = silu_f(acc[ai][bj][m][0][i]); o1[i] = silu_f(acc[ai][bj][m][1][i]); }
                        *(u32x4*)(G + (size_t)(row0 + ai * HALF + m * 16) * 2048 + col0 + bj * HALF) = pack8(o0, o1);
                    }
        } else {
            const int h = (u.pn - 8) & 3; const bool isk = u.pn >= 12; bf16_t* dst = isk ? K : Q; const float sc = isk ? 0.0625f : 1.0f;
            const int d0 = wc * 32 + 8 * fq;
#pragma unroll
            for (int ai = 0; ai < 2; ++ai)
#pragma unroll
                for (int m = 0; m < 4; ++m) {
                    const int row = row0 + ai * HALF + m * 16;
                    const f32x4* rp = (const f32x4*)(rot + ((size_t)row * 128 + d0) * 2);
                    f32x4 o1[2], o2[2];
#pragma unroll
                    for (int n = 0; n < 2; ++n) {
                        const f32x4 r0 = rp[2 * n], r1 = rp[2 * n + 1];
                        const f32x4 c = {r0[0], r0[2], r1[0], r1[2]}, s = {r0[1], r0[3], r1[1], r1[3]};
                        const f32x4 t1 = acc[ai][0][m][n], t2 = acc[ai][1][m][n];
                        o1[n] = (t1 * c - t2 * s) * sc; o2[n] = (t1 * s + t2 * c) * sc;
                    }
                    const size_t po = ((size_t)(row >> 4) * 32 + 8 * h + wc) * 512 + (fq * 16 + (row & 15)) * 8;
                    const float dec = isk ? __builtin_amdgcn_exp2f(log2f(1.0f - exp2f(-5.0f - (float)h)) * (float)(127 - (row & 127))) : 1.0f;
                    bf16_t* p = (isk ? KD : Q) + po;
                    *(u32x4*)p = pack8(o1[0] * dec, o1[1] * dec); *(u32x4*)(p + 4 * 512) = pack8(o2[0] * dec, o2[1] * dec);
                    if (m & 1) asm volatile("" ::: "memory");
                }
        }
    }
};
struct EpiRet3b {
    static constexpr bool PERM = true, AFTER_DRAIN = false;
    bf16_t* VT;
    __device__ __forceinline__ void operator()(const f32x4 (&acc)[2][2][4][2], const Unit& u, int wr, int wc, int fr, int fq) const {
        asm volatile("" : "+v"(fr), "+v"(fq));
        const int f0 = u.pm * BM + wr * 64 + fr, t0 = u.pn * BM + wc * 32 + 8 * fq;
#pragma unroll
        for (int ai = 0; ai < 2; ++ai)
#pragma unroll
            for (int m = 0; m < 4; ++m)
#pragma unroll
                for (int bj = 0; bj < 2; ++bj)
                    *(u32x4*)(VT + ((size_t)((f0 + ai * HALF + m * 16) >> 4) * 256 + ((t0 + bj * HALF) >> 5)) * 512 + (fq * 16 + fr) * 8) = pack8(acc[ai][bj][m][0], acc[ai][bj][m][1]);
    }
};
struct S5Order {
    int G, c;
    __host__ __device__ bool next(int i, Unit& u) const { const int L = i * G + c; if (L >= 256) return false; u.pm = L; u.pn = L >> 2; return true; }
    __device__ __forceinline__ void a_ready(const Unit&) const {}
    __device__ __forceinline__ void done(const Unit&) const {}
};
struct EpiS5A {
    static constexpr bool PERM = true, AFTER_DRAIN = false;
    float* Sloc;
    __device__ __forceinline__ void operator()(const f32x4 (&acc)[2][2][4][2], const Unit& u, int wr, int wc, int fr, int fq) const {
        asm volatile("" : "+v"(fr), "+v"(fq));
        const int g = u.pn, c0 = (u.pm & 3) * BM + wr * 64 + fr, n0 = wc * 32 + 8 * fq;
#pragma unroll
        for (int ai = 0; ai < 2; ++ai)
#pragma unroll
            for (int m = 0; m < 4; ++m) {
                float* p = Sloc + ((size_t)(c0 + ai * HALF + m * 16) * 64 + g) * 128 + n0;
                *(f32x4*)p = acc[ai][0][m][0]; *(f32x4*)(p + 4) = acc[ai][0][m][1];
            }
    }
};
struct EpiS5C {
    static constexpr bool PERM = true, AFTER_DRAIN = false;
    const bf16_t* XN; const float* dsk; bf16_t* YG;
    __device__ __forceinline__ void operator()(const f32x4 (&acc)[2][2][4][2], const Unit& u, int wr, int wc, int fr, int fq) const {
        asm volatile("" : "+v"(fr), "+v"(fq));
        const int g = u.pn, c0 = (u.pm & 3) * BM + wr * 64 + fr, ch = 16 * g + 8 * (fq & 1);
        const f32x4 d0 = *(const f32x4*)(dsk + ch), d1 = *(const f32x4*)(dsk + ch + 4);
#pragma unroll
        for (int ai = 0; ai < 2; ++ai)
#pragma unroll
            for (int m = 0; m < 4; ++m)
#pragma unroll
                for (int bj = 0; bj < 2; ++bj) {
                    const int i = 8 * bj + 2 * wc + (fq >> 1);
                    const size_t idx = (size_t)(16 * (c0 + ai * HALF + m * 16) + i) * 1024 + ch;
                    const u32x4 uv = *(const u32x4*)(XN + idx);
                    f32x4 y0 = acc[ai][bj][m][0], y1 = acc[ai][bj][m][1];
#pragma unroll
                    for (int t = 0; t < 2; ++t) {
                        y0[2 * t] += d0[2 * t] * __builtin_bit_cast(float, uv[t] << 16); y0[2 * t + 1] += d0[2 * t + 1] * __builtin_bit_cast(float, uv[t] & 0xffff0000u);
                        y1[2 * t] += d1[2 * t] * __builtin_bit_cast(float, uv[2 + t] << 16); y1[2 * t + 1] += d1[2 * t + 1] * __builtin_bit_cast(float, uv[2 + t] & 0xffff0000u);
                    }
#pragma unroll
                    for (int t = 0; t < 4; ++t) {
                        const float a = y0[t], b = y1[t];
                        y0[t] = a * __builtin_amdgcn_rcpf(1.f + __expf(-1.5957691216f * (a + 0.044715f * a * a * a)));
                        y1[t] = b * __builtin_amdgcn_rcpf(1.f + __expf(-1.5957691216f * (b + 0.044715f * b * b * b)));
                    }
                    *(u32x4*)(YG + idx) = pack8(y0, y1);
                }
    }
};
template <class Epi, class Sched, bool ALIGN_EPI = false, bool SP2 = false>
__device__ __forceinline__ void gemm_phase(PG8_LAS unsigned char* lds, const Gemm g, const Sched& S, const Epi& E) {
    int tid_ = threadIdx.x; asm volatile("" : "+v"(tid_));
    const int tid = tid_, wid = __builtin_amdgcn_readfirstlane(tid >> 6), lane = tid & 63, wr = wid >> 2, wc = wid & 3, fr = lane & 15, fq = lane >> 4;
    const int K = g.K, nt = K / BK;
    unsigned voffA[2], voffB[2];
#pragma unroll
    for (int i = 0; i < 2; ++i) { int R, C; stage_rc(tid * 16 + i * 8192, R, C); const int Rb = Epi::PERM ? ((R & ~31) + perm32(R & 31)) : R;
        voffA[i] = (unsigned)(R * K + C) * 2u; voffB[i] = (unsigned)(Rb * K + C) * 2u; }
    const size_t kstep = (size_t)(BK * 2);
    const size_t hstep = (size_t)HALF * K * 2;
    const size_t tstep = 2 * hstep;
    const unsigned ldsw = (unsigned)wid * 1024u;
    const int aoff = lds_byte(wr * 64 + fr, fq * 8), boff = lds_byte(wc * 32 + fr, fq * 8);
#define PG8_SA(b, h) (((b) * 2 + (h)) * HTB)
#define PG8_SB(b, h) ((4 + (b) * 2 + (h)) * HTB)
#define PG8_STAGE(bufoff, gbase, voff) do { _Pragma("unroll") for (int _i = 0; _i < 2; ++_i) \
        __builtin_amdgcn_global_load_lds((const unsigned*)((const char*)(gbase) + (voff)[_i]), (PG8_LAS unsigned*)(lds + (bufoff) + ldsw + _i * 8192), 16, 0, 0); } while (0)
#define PG8_LDA(dst, b, h) do { _Pragma("unroll") for (int m = 0; m < 4; ++m) _Pragma("unroll") for (int k = 0; k < 2; ++k) dst[m][k] = *(const PG8_LAS bf16x8*)(lds + PG8_SA(b, h) + aoff + m * 2048 + k * 1024); } while (0)
#define PG8_LDB(dst, b, h) do { _Pragma("unroll") for (int n = 0; n < 2; ++n) _Pragma("unroll") for (int k = 0; k < 2; ++k) dst[n][k] = *(const PG8_LAS bf16x8*)(lds + PG8_SB(b, h) + boff + n * 2048 + k * 1024); } while (0)
#define PG8_MMA(ai, bj, At, Bt) do { __builtin_amdgcn_s_setprio(1); _Pragma("unroll") for (int m = 0; m < 4; ++m) _Pragma("unroll") for (int n = 0; n < 2; ++n) _Pragma("unroll") for (int k = 0; k < 2; ++k) \
        acc[ai][bj][m][n] = __builtin_amdgcn_mfma_f32_16x16x32_bf16(Bt[n][k], At[m][k], acc[ai][bj][m][n], 0, 0, 0); __builtin_amdgcn_s_setprio(0); } while (0)
#define PG8_WAIT_V(n) asm volatile("s_waitcnt vmcnt(" #n ")" ::: "memory")
#define PG8_WAIT_L(n) asm volatile("s_waitcnt lgkmcnt(" #n ")" ::: "memory")
#define PG8_BAR __builtin_amdgcn_s_barrier()
#define PG8_SCHED __builtin_amdgcn_sched_barrier(0)
    Unit cur, nxt; int ui = 0;
    if (!S.next(0, cur)) return;
    f32x4 acc[2][2][4][2];
#pragma unroll
    for (int a = 0; a < 2; ++a)
#pragma unroll
        for (int b = 0; b < 2; ++b)
#pragma unroll
            for (int m = 0; m < 4; ++m)
#pragma unroll
                for (int n = 0; n < 2; ++n) acc[a][b][m][n] = (f32x4){0.f, 0.f, 0.f, 0.f};
    bf16x8 At[4][2], B0[2][2], B1[2][2];
    const char* cA = (const char*)g.A + (size_t)cur.pm * tstep; const char* cB = (const char*)g.Bt + (size_t)cur.pn * tstep;
    S.a_ready(cur);
    if constexpr (SP2) {
        PG8_STAGE(PG8_SB(0, 0), cB, voffB); PG8_STAGE(PG8_SB(0, 1), cB + hstep, voffB); PG8_STAGE(PG8_SA(0, 0), cA, voffA); PG8_STAGE(PG8_SA(0, 1), cA + hstep, voffA);
        if (wr == 1) PG8_BAR;
        PG8_WAIT_V(2); PG8_BAR;
        PG8_STAGE(PG8_SB(1, 0), cB + kstep, voffB); PG8_STAGE(PG8_SA(1, 0), cA + kstep, voffA); PG8_STAGE(PG8_SB(1, 1), cB + hstep + kstep, voffB);
        PG8_WAIT_V(6); PG8_BAR;
    } else {
        PG8_STAGE(PG8_SB(0, 0), cB, voffB); PG8_STAGE(PG8_SA(0, 0), cA, voffA); PG8_STAGE(PG8_SB(0, 1), cB + hstep, voffB); PG8_STAGE(PG8_SA(0, 1), cA + hstep, voffA);
        if (wr == 1) PG8_BAR;
        PG8_WAIT_V(4); PG8_BAR;
        PG8_STAGE(PG8_SB(1, 0), cB + kstep, voffB); PG8_STAGE(PG8_SA(1, 0), cA + kstep, voffA); PG8_STAGE(PG8_SB(1, 1), cB + hstep + kstep, voffB);
        PG8_WAIT_V(6); PG8_BAR;
    }
    for (;;) {
        const bool has_next = S.next(ui + 1, nxt);
        const char* nA = has_next ? (const char*)g.A + (size_t)nxt.pm * tstep : cA; const char* nB = has_next ? (const char*)g.Bt + (size_t)nxt.pn * tstep : cB;
        for (int t = 0; t < nt; t += 2) {
            const bool last = (t == nt - 2);
            const char* a1 = cA + (size_t)(t + 1) * kstep;
            const char* a2 = last ? nA : cA + (size_t)(t + 2) * kstep; const char* b2 = last ? nB : cB + (size_t)(t + 2) * kstep;
            const char* a3 = a2 + kstep; const char* b3 = b2 + kstep;
            if (last && has_next) S.a_ready(nxt);
            if constexpr (SP2) {
            PG8_LDB(B0, 0, 0); PG8_LDB(B1, 0, 1); PG8_SCHED; PG8_LDA(At, 0, 0); PG8_STAGE(PG8_SA(1, 1), a1 + hstep, voffA);
            PG8_WAIT_V(8); PG8_WAIT_L(0); PG8_BAR; PG8_MMA(0, 0, At, B0); PG8_MMA(0, 1, At, B1); PG8_BAR; PG8_SCHED;
            PG8_LDA(At, 0, 1); PG8_STAGE(PG8_SB(0, 0), b2, voffB); PG8_STAGE(PG8_SB(0, 1), b2 + hstep, voffB); PG8_STAGE(PG8_SA(0, 0), a2, voffA);
            PG8_WAIT_V(8); PG8_WAIT_L(0); PG8_BAR; PG8_MMA(1, 0, At, B0); PG8_MMA(1, 1, At, B1); PG8_BAR; PG8_SCHED;
            PG8_LDB(B0, 1, 0); PG8_LDB(B1, 1, 1); PG8_SCHED; PG8_LDA(At, 1, 0); PG8_STAGE(PG8_SA(0, 1), a2 + hstep, voffA);
            PG8_WAIT_V(8); PG8_WAIT_L(0); PG8_BAR; PG8_MMA(0, 0, At, B0); PG8_MMA(0, 1, At, B1); PG8_BAR; PG8_SCHED;
            PG8_LDA(At, 1, 1); PG8_STAGE(PG8_SB(1, 0), b3, voffB); PG8_STAGE(PG8_SB(1, 1), b3 + hstep, voffB); PG8_STAGE(PG8_SA(1, 0), a3, voffA);
            PG8_WAIT_V(8); PG8_WAIT_L(0); PG8_BAR; PG8_MMA(1, 0, At, B0); PG8_MMA(1, 1, At, B1); PG8_BAR; PG8_SCHED;
            } else {
            PG8_LDB(B0, 0, 0); PG8_SCHED; PG8_LDA(At, 0, 0); PG8_STAGE(PG8_SA(1, 1), a1 + hstep, voffA);
            PG8_WAIT_L(8); PG8_BAR; PG8_WAIT_L(0); PG8_MMA(0, 0, At, B0); PG8_BAR; PG8_SCHED;
            PG8_LDB(B1, 0, 1); PG8_STAGE(PG8_SB(0, 0), b2, voffB);
            PG8_BAR; PG8_WAIT_L(0); PG8_MMA(0, 1, At, B1); PG8_BAR;
            PG8_LDA(At, 0, 1); PG8_STAGE(PG8_SA(0, 0), a2, voffA);
            PG8_BAR; PG8_WAIT_L(0); PG8_MMA(1, 0, At, B0); PG8_BAR; PG8_SCHED;
            PG8_STAGE(PG8_SB(0, 1), b2 + hstep, voffB);
            PG8_WAIT_V(6); PG8_BAR; PG8_MMA(1, 1, At, B1); PG8_BAR;
            PG8_LDB(B0, 1, 0); PG8_SCHED; PG8_LDA(At, 1, 0); PG8_STAGE(PG8_SA(0, 1), a2 + hstep, voffA);
            PG8_WAIT_L(8); PG8_BAR; PG8_WAIT_L(0); PG8_MMA(0, 0, At, B0); PG8_BAR; PG8_SCHED;
            PG8_LDB(B1, 1, 1); PG8_STAGE(PG8_SB(1, 0), b3, voffB);
            PG8_BAR; PG8_WAIT_L(0); PG8_MMA(0, 1, At, B1); PG8_BAR;
            PG8_LDA(At, 1, 1); PG8_STAGE(PG8_SA(1, 0), a3, voffA);
            PG8_BAR; PG8_WAIT_L(0); PG8_MMA(1, 0, At, B0); PG8_BAR; PG8_SCHED;
            PG8_STAGE(PG8_SB(1, 1), b3 + hstep, voffB);
            PG8_WAIT_V(6); PG8_BAR; PG8_MMA(1, 1, At, B1); PG8_BAR;
            }
        }
        if constexpr (ALIGN_EPI) { if (wr == 0) PG8_BAR; }
        if constexpr (!Epi::AFTER_DRAIN) { E(acc, cur, wr, wc, (int)(threadIdx.x & 15u), (int)((threadIdx.x >> 4) & 3u)); S.done(cur); }
        if (!has_next) break;
#pragma unroll
        for (int a = 0; a < 2; ++a)
#pragma unroll
            for (int b = 0; b < 2; ++b)
#pragma unroll
                for (int m = 0; m < 4; ++m)
#pragma unroll
                    for (int n = 0; n < 2; ++n) acc[a][b][m][n] = (f32x4){0.f, 0.f, 0.f, 0.f};
        cur = nxt; cA = nA; cB = nB; ++ui;
        if constexpr (ALIGN_EPI) { if (wr == 1) PG8_BAR; }
    }
    PG8_WAIT_V(0);
    if constexpr (!ALIGN_EPI) { if (wr == 0) PG8_BAR; }
    PG8_BAR;
    if constexpr (Epi::AFTER_DRAIN) { E.fused(acc, cur, wr, wc, (int)(threadIdx.x & 15u), (int)((threadIdx.x >> 4) & 3u), lds, wid, (int)(threadIdx.x & 63u)); S.done(cur); }
#undef PG8_SA
#undef PG8_SB
#undef PG8_STAGE
#undef PG8_LDA
#undef PG8_LDB
#undef PG8_MMA
#undef PG8_WAIT_V
#undef PG8_WAIT_L
#undef PG8_BAR
#undef PG8_SCHED
}
}

#define LAS __attribute__((address_space(3)))
typedef unsigned short bf16;
typedef float f32x4 __attribute__((ext_vector_type(4)));
typedef float f32x2 __attribute__((ext_vector_type(2)));
typedef short bf16x8 __attribute__((ext_vector_type(8)));
typedef unsigned u32x2 __attribute__((ext_vector_type(2)));
typedef unsigned u32x4 __attribute__((ext_vector_type(4)));
typedef _Float16 h16x4 __attribute__((ext_vector_type(4)));

constexpr int NWAVES = 8, NTHR = 512;
constexpr int Mtok = 16384, Dm = 1024, Lseq = 8192, FF = 2816;
constexpr size_t MiB = 1u << 20;
constexpr size_t WS_MODS = 0;
constexpr size_t WS_APW = 256 * 1024;
constexpr size_t WS_EPW = 1024 * 1024;
constexpr size_t WS_BAR = 1792 * 1024;
constexpr size_t WS_WB = 2 * MiB;
constexpr size_t WS_WB2 = 14 * MiB;
constexpr size_t WS_XN = 22 * MiB;
constexpr size_t WS_ROT = 54 * MiB;
constexpr size_t WS_BIG = 70 * MiB;
constexpr size_t WS_H = WS_BIG;
constexpr size_t WS_G = WS_BIG;
constexpr size_t WS_Q = WS_BIG + 64 * MiB;
constexpr size_t WS_K = WS_BIG + 80 * MiB;
constexpr size_t WS_KT = WS_BIG + 96 * MiB;
constexpr size_t WS_VT = WS_BIG + 112 * MiB;
constexpr size_t WS_KV = WS_BIG + 144 * MiB;
constexpr size_t WS_XH = WS_BIG;
constexpr size_t WS_SLOC = WS_BIG + 48 * MiB;
constexpr size_t WS_YG = WS_BIG + 80 * MiB;
constexpr size_t WS_TC = WS_BIG + 112 * MiB;
constexpr size_t WS_SP = WS_BIG + 124 * MiB;
constexpr size_t WS_END = WS_BIG + 208 * MiB;

constexpr int LDS_BYTES = 135168;

__device__ __forceinline__ unsigned f2bf(float f) { unsigned u = __builtin_bit_cast(unsigned, f); return (u + 0x7fffu + ((u >> 16) & 1u)) >> 16; }
__device__ __forceinline__ unsigned pk2(float lo, float hi) { return f2bf(lo) | (f2bf(hi) << 16); }
__device__ __forceinline__ float bf2f(unsigned short h) { return __builtin_bit_cast(float, (unsigned)h << 16); }
__device__ __forceinline__ float shx(float v, int o, int lane) { return __builtin_bit_cast(float, __builtin_amdgcn_ds_bpermute((lane ^ o) << 2, __builtin_bit_cast(int, v))); }
__device__ __forceinline__ float wave_sum(float v, int lane) {
#pragma unroll
    for (int o = 1; o < 64; o <<= 1) v += shx(v, o, lane);
    return v;
}

enum { K_PRO = 0, K_ROW, K_FFN_IN, K_FFN_OUT, K_G3, K_R1, K_R2, K_R3, K_RETOUT, K_S5A, K_S5B, K_S5C, K_GLU, K_FINAL };
constexpr int MAXPH = 64;
struct Params {
    const float* x; const float* c; const int* pos; const float* ada_w; const float* ada_b; const float* norm_g;
    const float* ffn_w_in; const float* ffn_w_out; const float* ret_w_in; const float* ret_w_out;
    const float* a_re; const float* a_im; const float* b_re; const float* b_im; const float* c_re; const float* c_im;
    const float* s5_d; const float* log_dt; const float* w_glu; const float* final_g;
    float* out; unsigned char* ws;
    int nph; int pad;
    unsigned char ph[MAXPH][4];
};

typedef const __attribute__((address_space(4))) Params* KP;

__device__ __forceinline__ int map_row(int mode, int hv, int n) {
    if (mode == 1) { const int up = n >= hv ? 1 : 0, j = n - up * hv; return 256 * (j >> 7) + 128 * up + (j & 127); }
    if (mode == 2) { return n < 4096 ? n + 2048 : n - 4096; }
    return n;
}
__device__ __forceinline__ void conv_item(const float* W, int K, int N, bf16* WT, int mode, int hv, LAS float* scr, int item, int lane) {
    const int nblk = N / 32, kb = item / nblk, nb = item % nblk, k0 = 64 * kb, n0 = 32 * nb;
    float tv[32];
#pragma unroll
    for (int i = 0; i < 32; ++i) tv[i] = __builtin_nontemporal_load(&W[(size_t)(k0 + 2 * i + (lane >> 5)) * N + n0 + (lane & 31)]);
#pragma unroll
    for (int i = 0; i < 32; ++i) scr[(2 * i + (lane >> 5)) * 33 + (lane & 31)] = tv[i];
    asm volatile("s_waitcnt lgkmcnt(0)" ::: "memory");
    const int c = lane & 7;
#pragma unroll
    for (int j = 0; j < 4; ++j) { const int n = (lane >> 3) + 8 * j; const LAS float* s = scr + (8 * c) * 33 + n;
        u32x4 o; o.x = pk2(s[0 * 33], s[1 * 33]); o.y = pk2(s[2 * 33], s[3 * 33]); o.z = pk2(s[4 * 33], s[5 * 33]); o.w = pk2(s[6 * 33], s[7 * 33]);
        *(u32x4*)(WT + (size_t)map_row(mode, hv, n0 + n) * K + k0 + 8 * c) = o; }
    asm volatile("s_waitcnt lgkmcnt(0)" ::: "memory");
}
__device__ __forceinline__ void conv_job(const float* W, int K, int N, bf16* WT, int mode, int hv, LAS float* scr, int gw, int ngw, int lane) {
    const int nitems = (K / 64) * (N / 32);
    for (int it = gw; it < nitems; it += ngw) conv_item(W, K, N, WT, mode, hv, scr, it, lane);
}

__device__ __forceinline__ void row_pass(const void* xin, int in_f32, const float* gvec, const float* sh, const float* sc, bf16* XN, bf16* XH, bf16* XC, int gw, int ngw, int lane) {
    for (int m0 = gw; m0 < Mtok; m0 += 4 * ngw) {
        f32x4 v[4][4]; float s[4];
#pragma unroll
        for (int r = 0; r < 4; ++r) {
            const int m = m0 + r * ngw; const size_t ro = (size_t)(m < Mtok ? m : m0) * Dm;
            if (in_f32) {
#pragma unroll
                for (int j = 0; j < 4; ++j) v[r][j] = __builtin_nontemporal_load((const f32x4*)((const float*)xin + ro) + lane + 64 * j);
            } else {
#pragma unroll
                for (int j = 0; j < 4; ++j) v[r][j] = __builtin_convertvector(*((const h16x4*)((const bf16*)xin + ro) + lane + 64 * j), f32x4);
            }
        }
#pragma unroll
        for (int r = 0; r < 4; ++r) {
            float a = 0.f;
#pragma unroll
            for (int j = 0; j < 4; ++j) a += (v[r][j][0] * v[r][j][0] + v[r][j][1] * v[r][j][1]) + (v[r][j][2] * v[r][j][2] + v[r][j][3] * v[r][j][3]);
            s[r] = __builtin_amdgcn_rsqf(wave_sum(a, lane) * (1.0f / Dm) + 1e-6f);
        }
#pragma unroll
        for (int j = 0; j < 4; ++j) {
            const int col = 4 * lane + 256 * j;
            const f32x4 g = *(const f32x4*)(gvec + col);
#pragma unroll
            for (int r = 0; r < 4; ++r) {
                const int m = m0 + r * ngw;
                if (m < Mtok) {
                    const int b = m >> 13;
                    const f32x4 s1 = *(const f32x4*)(sc + b * 9216 + col), s0 = *(const f32x4*)(sh + b * 9216 + col);
                    const f32x4 y = (v[r][j] * s[r] * g) * (s1 + 1.0f) + s0;
                    const unsigned long long pv = (unsigned long long)pk2(y[0], y[1]) | ((unsigned long long)pk2(y[2], y[3]) << 32);
                    *((unsigned long long*)(XN + (size_t)m * Dm) + lane + 64 * j) = pv;
                    if (XC) *((h16x4*)(XC + (size_t)m * Dm) + lane + 64 * j) = __builtin_convertvector(v[r][j], h16x4);
                    if (XH) *(unsigned long long*)(XH + ((size_t)(col >> 4) * 1024 + (m >> 4)) * 384 + 16 * (m & 15) + (col & 15)) = pv;
                }
            }
        }
    }
}
__device__ __forceinline__ void final_norm(const bf16* xr_, float* outp, const float* gvec, int gw, int ngw, int lane) {
    for (int m0 = gw; m0 < Mtok; m0 += 4 * ngw) {
        f32x4 v[4][4]; float s[4];
#pragma unroll
        for (int r = 0; r < 4; ++r) {
            const int m = m0 + r * ngw; const size_t ro = (size_t)(m < Mtok ? m : m0) * Dm;
#pragma unroll
            for (int j = 0; j < 4; ++j) v[r][j] = __builtin_convertvector(*((const h16x4*)(xr_ + ro) + lane + 64 * j), f32x4);
        }
#pragma unroll
        for (int r = 0; r < 4; ++r) {
            float a = 0.f;
#pragma unroll
            for (int j = 0; j < 4; ++j) a += (v[r][j][0] * v[r][j][0] + v[r][j][1] * v[r][j][1]) + (v[r][j][2] * v[r][j][2] + v[r][j][3] * v[r][j][3]);
            s[r] = __builtin_amdgcn_rsqf(wave_sum(a, lane) * (1.0f / Dm) + 1e-6f);
        }
#pragma unroll
        for (int j = 0; j < 4; ++j) {
            const f32x4 g = *(const f32x4*)(gvec + 4 * lane + 256 * j);
#pragma unroll
            for (int r = 0; r < 4; ++r) { const int m = m0 + r * ngw; if (m < Mtok) __builtin_nontemporal_store(v[r][j] * s[r] * g, (f32x4*)(outp + (size_t)m * Dm) + lane + 64 * j); }
        }
    }
}

__device__ __forceinline__ void prologue(KP P, LAS unsigned char* lds, int bid, int G, int tid, int w, int lane) {
    float* mods = (float*)(P->ws + WS_MODS);
    LAS float* red = (LAS float*)lds;
    for (int it = bid; it < 72; it += G) {
        const int l = it / 36, cb = it % 36;
        f32x4 a0 = {0.f, 0.f, 0.f, 0.f}, a1 = {0.f, 0.f, 0.f, 0.f};
        const float* wp = P->ada_w + ((size_t)l * 1024 + 128 * w) * 9216 + 256 * cb + 4 * lane;
#pragma unroll 16
        for (int kk = 0; kk < 128; ++kk) {
            const f32x4 wv = __builtin_nontemporal_load((const f32x4*)(wp + (size_t)kk * 9216));
            const float c0 = P->c[128 * w + kk], c1 = P->c[1024 + 128 * w + kk];
            const float s0 = c0 * __builtin_amdgcn_rcpf(1.f + __expf(-c0)), s1 = c1 * __builtin_amdgcn_rcpf(1.f + __expf(-c1));
            a0 += wv * s0; a1 += wv * s1;
        }
#pragma unroll
        for (int i = 0; i < 4; ++i) { red[(w * 2 + 0) * 256 + 4 * lane + i] = a0[i]; red[(w * 2 + 1) * 256 + 4 * lane + i] = a1[i]; }
        __syncthreads();
        { const int b = tid >> 8, col = tid & 255; float s = 0.f;
#pragma unroll
          for (int ww = 0; ww < 8; ++ww) s += red[(ww * 2 + b) * 256 + col];
          mods[(size_t)(l * 2 + b) * 9216 + 256 * cb + col] = s + P->ada_b[l * 9216 + 256 * cb + col]; }
        __syncthreads();
    }
    if (G > 144 && bid < 72) return;
    const int gt = (G > 144 ? bid - 72 : bid) * NTHR + tid, ngt = (G > 144 ? G - 72 : G) * NTHR;
    float* rot = (float*)(P->ws + WS_ROT);
    for (int e = gt; e < Mtok * 128; e += ngt) {
        const int m = e >> 7, d = e & 127;
        double invf = 1.0, bs = 0.9305720409296990;
#pragma unroll
        for (int q = 0; q < 7; ++q) { if ((d >> q) & 1) invf *= bs; bs *= bs; }
        const double a = (double)P->pos[m] * invf;
        const double kq = __builtin_rint(a * 0.15915494309189535);
        const float fr_ = (float)__builtin_fma(a, 0.15915494309189535, -kq);
        *(f32x2*)(rot + (size_t)e * 2) = (f32x2){__builtin_amdgcn_cosf(fr_), __builtin_amdgcn_sinf(fr_)};
    }
    f32x2* apw = (f32x2*)(P->ws + WS_APW); f32x2* epw = (f32x2*)(P->ws + WS_EPW);
    for (int e = gt; e < 64 * 64 * 17; e += ngt) {
        const int t = e % 17, gp = e / 17, g = gp >> 6;
        const float dt = __expf(P->log_dt[g]);
        const float are = P->a_re[gp], aim = P->a_im[gp];
        const float mg = __expf((float)t * dt * are);
        const double an = (double)t * (double)dt * (double)aim * 0.15915494309189535;
        const float fa = (float)(an - __builtin_rint(an));
        const float pr = mg * __builtin_amdgcn_cosf(fa), pi = mg * __builtin_amdgcn_sinf(fa);
        apw[e] = (f32x2){pr, pi};
        if (t < 16) {
            const float xx = dt * are;
            const float em1 = xx * (1.f + xx * (0.5f + xx * (0.16666667f + xx * (0.041666668f + xx * 0.0083333338f))));
            const double a1 = (double)dt * (double)aim * 0.15915494309189535;
            const float f1 = (float)(a1 - __builtin_rint(a1)); const double a2 = 0.5 * a1; const float f2 = (float)(a2 - __builtin_rint(a2));
            const float c1 = __builtin_amdgcn_cosf(f1), s1 = __builtin_amdgcn_sinf(f1), sh = __builtin_amdgcn_sinf(f2);
            const float br = em1 * c1 - 2.f * sh * sh, bi = (1.f + em1) * s1;
            const float den = are * are + aim * aim;
            const float wr = (br * are + bi * aim) / den, wi = (bi * are - br * aim) / den;
            epw[gp * 16 + t] = (f32x2){pr * wr - pi * wi, pr * wi + pi * wr};
        }
    }
}

__device__ __forceinline__ void s5_build(KP P, int gt, int ngt) {
    const f32x2* apw = (const f32x2*)(P->ws + WS_APW); const f32x2* epw = (const f32x2*)(P->ws + WS_EPW);
    bf16* TC = (bf16*)(P->ws + WS_TC); bf16* SP = (bf16*)(P->ws + WS_SP);
    for (int e = gt; e < 64 * 16 * 16 * 16; e += ngt) {
        const int kp = e & 15, k = (e >> 4) & 15, d = (e >> 8) & 15, g = e >> 12;
        float acc = 0.f;
        for (int p = 0; p < 64; ++p) {
            const f32x2 E = epw[(g * 64 + p) * 16 + d];
            const float br = P->b_re[((size_t)g * 64 + p) * 16 + kp], bi = P->b_im[((size_t)g * 64 + p) * 16 + kp];
            const float zr = E.x * br - E.y * bi, zi = E.x * bi + E.y * br;
            const float cr = P->c_re[((size_t)g * 16 + k) * 64 + p], ci = P->c_im[((size_t)g * 16 + k) * 64 + p];
            acc += cr * zr - ci * zi;
        }
        const bf16 v = (bf16)f2bf(acc);
        bf16* tg = TC + (size_t)g * 256 * 384;
        for (int j = 0; j + d < 16; ++j) { const int i = j + d; tg[(16 * i + k) * 384 + 16 * j + kp] = v; }
        if (d >= 1) for (int i = 0; i + d < 16; ++i) { const int j = i + d; tg[(16 * i + k) * 384 + 16 * j + kp] = 0; }
    }
    for (int e = gt; e < 64 * 64 * 16 * 16; e += ngt) {
        const int kp = e & 15, j = (e >> 4) & 15, p = (e >> 8) & 63, g = e >> 14;
        const f32x2 E = epw[(g * 64 + p) * 16 + (15 - j)];
        const float br = P->b_re[((size_t)g * 64 + p) * 16 + kp], bi = P->b_im[((size_t)g * 64 + p) * 16 + kp];
        bf16* sg = SP + (size_t)g * 256 * 384;
        sg[(2 * p) * 384 + 16 * j + kp] = (bf16)f2bf(E.x * br - E.y * bi);
        sg[(2 * p + 1) * 384 + 16 * j + kp] = (bf16)f2bf(E.x * bi + E.y * br);
    }
    for (int e = gt; e < 64 * 256 * 192; e += ngt) {
        const int g = e / (256 * 192), r = (e / 192) & 255, cp = e % 192;
        unsigned* sg = (unsigned*)(SP + (size_t)g * 256 * 384 + (size_t)r * 384);
        if (r >= 128 || cp >= 128) sg[cp] = 0u;
    }
    for (int e = gt; e < 64 * 16 * 16 * 64; e += ngt) {
        const int p = e & 63, k = (e >> 6) & 15, i = (e >> 10) & 15, g = e >> 14;
        const f32x2 A = apw[(g * 64 + p) * 17 + i + 1];
        const float cr = P->c_re[((size_t)g * 16 + k) * 64 + p], ci = P->c_im[((size_t)g * 16 + k) * 64 + p];
        const float wr = cr * A.x - ci * A.y, wi = cr * A.y + ci * A.x;
        *(unsigned*)(TC + (size_t)g * 256 * 384 + (16 * i + k) * 384 + 256 + 2 * p) = pk2(wr, -wi);
    }
}

#define MFMA16(a, b, c) __builtin_amdgcn_mfma_f32_16x16x32_bf16((a), (b), (c), 0, 0, 0)

__device__ __forceinline__ void s5b_phase(const float* Sloc, const f32x2* apw, bf16* XH, LAS unsigned char* lds, int bid, int G, int w, int lane) {
    LAS f32x2* E = (LAS f32x2*)lds;
    for (int u = bid; u < 128; u += G) {
        const int b = u >> 6, g = u & 63, p = lane;
        const f32x2 A16 = apw[(g * 64 + p) * 17 + 16];
        const float* sp = Sloc + ((size_t)(b * 512 + 64 * w) * 64 + g) * 128 + 2 * p;
        bf16* hp = XH + ((size_t)g * 1024 + b * 512 + 64 * w) * 384 + 256 + 2 * p;
        float er = 0.f, ei = 0.f;
#pragma unroll 1
        for (int hf = 0; hf < 2; ++hf) {
            f32x2 sv[32];
#pragma unroll
            for (int q = 0; q < 32; ++q) sv[q] = *(const f32x2*)(sp + (size_t)(32 * hf + q) * 8192);
#pragma unroll
            for (int q = 0; q < 32; ++q) { const float nr = A16.x * er - A16.y * ei + sv[q].x, ni = A16.x * ei + A16.y * er + sv[q].y; er = nr; ei = ni; }
        }
        E[w * 64 + p] = (f32x2){er, ei};
        float pr = A16.x, pi = A16.y;
#pragma unroll
        for (int q = 0; q < 6; ++q) { const float nr = pr * pr - pi * pi, ni = 2.f * pr * pi; pr = nr; pi = ni; }
        __syncthreads();
        float hr = 0.f, hi = 0.f;
        for (int k = 0; k < w; ++k) { const f32x2 e = E[k * 64 + p]; const float nr = pr * hr - pi * hi + e.x, ni = pr * hi + pi * hr + e.y; hr = nr; hi = ni; }
#pragma unroll 1
        for (int hf = 0; hf < 2; ++hf) {
            f32x2 sv[32];
#pragma unroll
            for (int q = 0; q < 32; ++q) sv[q] = *(const f32x2*)(sp + (size_t)(32 * hf + q) * 8192);
#pragma unroll
            for (int q = 0; q < 32; ++q) {
                *(unsigned*)(hp + (size_t)(32 * hf + q) * 384) = pk2(hr, hi);
                const float nr = A16.x * hr - A16.y * hi + sv[q].x, ni = A16.x * hi + A16.y * hr + sv[q].y; hr = nr; hi = ni;
            }
        }
        __syncthreads();
    }
}
__device__ __forceinline__ void r1_phase(const bf16* KD, const bf16* VT, bf16* KV, LAS unsigned char* lds, int bid, int G, int w, int lane_) {
    for (int u = bid; u < 256; u += G) {
        int lane = lane_; asm volatile("" : "+v"(lane));
        const int fr = lane & 15, fq = lane >> 4;
        const int h = u >> 6, n = u & 63;
        const char* kdu = (const char*)(KD + ((size_t)(8 * n) * 32 + 8 * h) * 512);
        const char* vtu = (const char*)(VT + ((size_t)(32 * h) * 256 + 4 * n) * 512);
#pragma unroll
        for (int q = 0; q < 8; ++q)
            __builtin_amdgcn_global_load_lds((const unsigned*)(kdu + (size_t)(w * 32 + q) * 1024 + lane * 16), (LAS unsigned*)(lds + (8 * w + q) * 1024), 16, 0, 0);
#define R1_DMA(p, bufoff) do { _Pragma("unroll") for (int q_ = 0; q_ < 4; ++q_) \
        __builtin_amdgcn_global_load_lds((const unsigned*)(vtu + (size_t)(8 * (p) + w) * 262144 + q_ * 1024 + lane * 16), (LAS unsigned*)(lds + (bufoff) + (4 * w + q_) * 1024), 16, 0, 0); } while (0)
        R1_DMA(0, 65536);
        asm volatile("s_waitcnt vmcnt(0)" ::: "memory");
        __syncthreads();
        bf16x8 af[2][4];
#pragma unroll
        for (int rbl = 0; rbl < 2; ++rbl)
#pragma unroll
            for (int ks = 0; ks < 4; ++ks) {
                const LAS unsigned short* base = (const LAS unsigned short*)(lds + ((2 * ks + (fq >> 1)) * 8 + w) * 1024) + ((2 * rbl + (fr >> 3)) * 16 + 8 * (fq & 1)) * 8 + (fr & 7);
                bf16x8 v;
#pragma unroll
                for (int jj = 0; jj < 8; ++jj) v[jj] = (short)base[jj * 8];
                af[rbl][ks] = v;
            }
#pragma unroll 1
        for (int p = 0; p < 4; ++p) {
            LAS unsigned char* buf = lds + 65536 + (p & 1) * 32768;
            if (p + 1 < 4) R1_DMA(p + 1, 65536 + ((p + 1) & 1) * 32768);
            f32x4 acc[2][8];
#pragma unroll
            for (int rbl = 0; rbl < 2; ++rbl)
#pragma unroll
                for (int cb = 0; cb < 8; ++cb) acc[rbl][cb] = (f32x4){0.f, 0.f, 0.f, 0.f};
#pragma unroll
            for (int cb = 0; cb < 8; ++cb)
#pragma unroll
                for (int ks = 0; ks < 4; ++ks) {
                    const bf16x8 vf = *(const LAS bf16x8*)(buf + (cb * 4 + ks) * 1024 + lane * 16);
                    acc[0][cb] = MFMA16(af[0][ks], vf, acc[0][cb]); acc[1][cb] = MFMA16(af[1][ks], vf, acc[1][cb]);
                }
#pragma unroll
            for (int rbl = 0; rbl < 2; ++rbl)
#pragma unroll
                for (int cb = 0; cb < 8; ++cb) {
                    const f32x4 a = acc[rbl][cb];
                    *(u32x2*)(KV + (size_t)u * 131072 + ((8 * p + cb) * 8 + w) * 512 + ((2 * rbl + (fq >> 1)) * 16 + fr) * 8 + 4 * (fq & 1)) = (u32x2){pk2(a[0], a[1]), pk2(a[2], a[3])};
                }
            asm volatile("s_waitcnt vmcnt(0)" ::: "memory");
            __syncthreads();
        }
    }
}
__device__ __forceinline__ void r2_phase(bf16* KV, int gt, int ngt) {
    for (int it = gt; it < 131072; it += ngt) {
        const int h = it >> 15, rem = it & 32767;
        const float gC = exp2f(128.0f * log2f(1.0f - exp2f(-5.0f - (float)h)));
        float s0 = 0.f, s1 = 0.f, s2 = 0.f, s3 = 0.f;
        bf16* base = KV + (size_t)h * 64 * 131072 + (size_t)rem * 4;
        for (int n0 = 0; n0 < 64; n0 += 8) {
            u32x2 kv[8];
#pragma unroll
            for (int q = 0; q < 8; ++q) kv[q] = *(const u32x2*)(base + (size_t)(n0 + q) * 131072);
#pragma unroll
            for (int q = 0; q < 8; ++q) {
                *(u32x2*)(base + (size_t)(n0 + q) * 131072) = (u32x2){pk2(s0, s1), pk2(s2, s3)};
                s0 = s0 * gC + __builtin_bit_cast(float, kv[q].x << 16); s1 = s1 * gC + __builtin_bit_cast(float, kv[q].x & 0xffff0000u);
                s2 = s2 * gC + __builtin_bit_cast(float, kv[q].y << 16); s3 = s3 * gC + __builtin_bit_cast(float, kv[q].y & 0xffff0000u);
            }
        }
    }
}
__device__ __forceinline__ const char* r3_stage_src(int s, const char* kb, const char* st, const char* vt, int c) {
    const int slot = c >> 6, lp = (c & 63) * 16;
    if (s < 2) return kb + (size_t)((4 * s + (slot >> 3)) * 32 + (slot & 7)) * 1024 + lp;
    if (s < 10) return st + (size_t)(s - 2) * 32768 + (size_t)c * 16;
    return vt + (size_t)slot * 262144 + (size_t)(s - 10) * 1024 + lp;
}
__device__ __forceinline__ void r3_phase(const bf16* Q, const bf16* Kb, const bf16* VT, const bf16* ST, bf16* Gb, LAS unsigned char* lds, int bid, int G, int tid_, int w, int lane_) {
    LAS bf16* sw = (LAS bf16*)(lds + 65536 + w * 4352);
    LAS bf16* ow = (LAS bf16*)(lds + w * 8448);
    for (int u = bid; u < 256; u += G) {
        int tid = tid_, lane = lane_; asm volatile("" : "+v"(tid), "+v"(lane));
        const int fr = lane & 15, fq = lane >> 4;
        const int h = u >> 6, n = u & 63;
        const float lg = log2f(1.0f - exp2f(-5.0f - (float)h));
        const char* kbu = (const char*)(Kb + ((size_t)(8 * n) * 32 + 8 * h) * 512);
        const char* stu = (const char*)(ST + (size_t)u * 131072);
        const char* vtu = (const char*)(VT + ((size_t)(32 * h) * 256 + 4 * n) * 512);
        bf16x8 qf[8];
        { const char* qtu = (const char*)(Q + ((size_t)(8 * n + w) * 32 + 8 * h) * 512);
#pragma unroll
          for (int ks = 0; ks < 8; ++ks) qf[ks] = *(const bf16x8*)(qtu + ks * 1024 + lane * 16); }
#define R3_DMA(sg, bufoff) do { _Pragma("unroll") for (int q_ = 0; q_ < 4; ++q_) \
        __builtin_amdgcn_global_load_lds((const unsigned*)r3_stage_src((sg), kbu, stu, vtu, (4 * w + q_) * 64 + lane), (LAS unsigned*)(lds + (bufoff) + (4 * w + q_) * 1024), 16, 0, 0); } while (0)
        R3_DMA(0, 0);
        asm volatile("s_waitcnt vmcnt(0)" ::: "memory");
        __syncthreads();
        const int jbmax = w | 1, ksmax = w >> 1;
        f32x4 as[8];
#pragma unroll
        for (int jb = 0; jb < 8; ++jb) as[jb] = (f32x4){0.f, 0.f, 0.f, 0.f};
        f32x4 o[32];
#pragma unroll
        for (int s = 0; s < 14; ++s) {
            LAS unsigned char* buf = lds + (s & 1) * 32768;
            if (s + 1 < 14) R3_DMA(s + 1, ((s + 1) & 1) * 32768);
            if (s < 2) {
#pragma unroll
                for (int jl = 0; jl < 4; ++jl)
                    if (4 * s + jl <= jbmax) {
#pragma unroll
                        for (int ks = 0; ks < 8; ++ks) { const bf16x8 kf = *(const LAS bf16x8*)(buf + (jl * 8 + ks) * 1024 + lane * 16); as[4 * s + jl] = MFMA16(qf[ks], kf, as[4 * s + jl]); }
                        asm volatile("" ::: "memory");
                    }
                if (s == 1) {
#pragma unroll
                    for (int jb = 0; jb < 8; ++jb)
                        if (jb <= jbmax) {
#pragma unroll
                            for (int ii = 0; ii < 4; ++ii) {
                                const int i = 16 * w + 4 * fq + ii, j = 16 * jb + fr;
                                const float v = (i >= j) ? as[jb][ii] * __builtin_amdgcn_exp2f(lg * (float)(i - 127)) : 0.f;
                                sw[(4 * fq + ii) * 136 + j] = (bf16)f2bf(v);
                            }
                        }
                }
            } else if (s < 10) {
                if (s == 2) {
#pragma unroll
                    for (int eb = 0; eb < 32; ++eb) o[eb] = (f32x4){0.f, 0.f, 0.f, 0.f};
                }
#pragma unroll
                for (int el = 0; el < 4; ++el)
#pragma unroll
                    for (int ks = 0; ks < 8; ++ks) { const bf16x8 sf = *(const LAS bf16x8*)(buf + (el * 8 + ks) * 1024 + lane * 16); o[4 * (s - 2) + el] = MFMA16(qf[ks], sf, o[4 * (s - 2) + el]); if ((ks & 3) == 3) asm volatile("" ::: "memory"); }
                if (s == 9) {
                    float qd[4];
#pragma unroll
                    for (int ii = 0; ii < 4; ++ii) qd[ii] = __builtin_amdgcn_exp2f(lg * (float)(16 * w + 4 * fq + ii + 1));
#pragma unroll
                    for (int eb = 0; eb < 32; ++eb)
#pragma unroll
                        for (int ii = 0; ii < 4; ++ii) o[eb][ii] *= qd[ii];
                }
            } else {
                if (s - 10 <= ksmax) {
                    const bf16x8 af = *(const LAS bf16x8*)(sw + fr * 136 + 32 * (s - 10) + 8 * fq);
#pragma unroll
                    for (int eb = 0; eb < 32; ++eb) { const bf16x8 vf = *(const LAS bf16x8*)(buf + eb * 1024 + lane * 16); o[eb] = MFMA16(af, vf, o[eb]); if ((eb & 7) == 7) asm volatile("" ::: "memory"); }
                }
            }
            asm volatile("s_waitcnt vmcnt(0)" ::: "memory");
            __syncthreads();
        }
        float mean[4], rstd[4];
#pragma unroll
        for (int ii = 0; ii < 4; ++ii) {
            float sm = 0.f;
#pragma unroll
            for (int eb = 0; eb < 32; ++eb) sm += o[eb][ii];
            sm += shx(sm, 1, lane); sm += shx(sm, 2, lane); sm += shx(sm, 4, lane); sm += shx(sm, 8, lane);
            const float mu = sm * (1.0f / 512.0f); float q = 0.f;
#pragma unroll
            for (int eb = 0; eb < 32; ++eb) { const float dd = o[eb][ii] - mu; q += dd * dd; }
            q += shx(q, 1, lane); q += shx(q, 2, lane); q += shx(q, 4, lane); q += shx(q, 8, lane);
            mean[ii] = mu; rstd[ii] = __builtin_amdgcn_rsqf(q * (1.0f / 512.0f) + 1e-5f);
        }
#pragma unroll
        for (int hf = 0; hf < 2; ++hf) {
#pragma unroll
            for (int e2 = 0; e2 < 16; ++e2)
#pragma unroll
                for (int ii = 0; ii < 4; ++ii) { ow[(4 * fq + ii) * 264 + 16 * e2 + fr] = (bf16)f2bf((o[16 * hf + e2][ii] - mean[ii]) * rstd[ii]); if (ii == 3 && (e2 & 3) == 3) asm volatile("" ::: "memory"); }
            __syncthreads();
#pragma unroll 1
            for (int qh = 0; qh < 2; ++qh) {
                u32x4 gq[4];
#pragma unroll
                for (int q4 = 0; q4 < 4; ++q4) { const int c = lane + 64 * (4 * qh + q4); gq[q4] = *(const u32x4*)(Gb + (size_t)(128 * n + 16 * w + (c >> 5)) * 2048 + 512 * h + 256 * hf + 8 * (c & 31)); }
#pragma unroll
                for (int q4 = 0; q4 < 4; ++q4) {
                    const int c = lane + 64 * (4 * qh + q4), row = c >> 5, c8 = c & 31;
                    const u32x4 ov = *(const LAS u32x4*)(ow + row * 264 + 8 * c8);
                    bf16* gp = Gb + (size_t)(128 * n + 16 * w + row) * 2048 + 512 * h + 256 * hf + 8 * c8;
                    const u32x4 gv = gq[q4];
                    u32x4 r;
#pragma unroll
                    for (int t = 0; t < 4; ++t) {
                        const float a0 = __builtin_bit_cast(float, ov[t] << 16) * __builtin_bit_cast(float, gv[t] << 16);
                        const float a1 = __builtin_bit_cast(float, ov[t] & 0xffff0000u) * __builtin_bit_cast(float, gv[t] & 0xffff0000u);
                        r[t] = pk2(a0, a1);
                    }
                    *(u32x4*)gp = r;
                }
            }
            __syncthreads();
        }
    }
}

#define XB_TMO      128
#define XB_XCNT(j)  (256  + 64 * (j))
#define XB_XSUB(j)  (1280 + 64 * (j))
#define XB_XGEN(j)  (2304 + 64 * (j))
#define XB_TOP      3328
#define XB_TOPGEN   3392
#define XCD_BAR_WORDS 3456
#define XB_SPIN_CAP (1u << 18)

__device__ __forceinline__ unsigned xb_ld(unsigned* p)              { return __hip_atomic_load(p, __ATOMIC_RELAXED, __HIP_MEMORY_SCOPE_AGENT); }
__device__ __forceinline__ unsigned xb_add(unsigned* p, unsigned v) { return __hip_atomic_fetch_add(p, v, __ATOMIC_RELAXED, __HIP_MEMORY_SCOPE_AGENT); }
__device__ __forceinline__ unsigned xb_xcc_id() { return (unsigned)__builtin_amdgcn_s_getreg((3 << 11) | 20) & 0xFu; }
#define XB_SPIN(cond, bar) do { unsigned _sp = 0; while (cond) { __builtin_amdgcn_s_sleep(1); \
    if ((++_sp & 255u) == 0u) { if (xb_ld(&(bar)[XB_TMO])) break; if (_sp > XB_SPIN_CAP) { atomicAdd(&(bar)[XB_TMO], 1u); break; } } } } while (0)

struct XcdBarrier {
    unsigned* bar; unsigned x;
    volatile LAS unsigned* st;
};

__device__ __forceinline__ XcdBarrier xcd_barrier_post(unsigned* bar, volatile LAS unsigned* st) {
    XcdBarrier b; b.bar = bar; b.x = xb_xcc_id(); b.st = st;
    if (threadIdx.x == 0) (void)xb_add(&bar[XB_XCNT(b.x)], 1u);
    return b;
}
__device__ __forceinline__ void xcd_barrier_complete(unsigned* bar, unsigned x, unsigned& nloc, unsigned& nx) {
    const unsigned G = gridDim.x * gridDim.y * gridDim.z;
    unsigned sum, cnt, mine, sp = 0u;
    for (;;) {
        sum = 0u; cnt = 0u; mine = 0u;
#pragma unroll
        for (unsigned j = 0; j < 16; ++j) { const unsigned c = xb_ld(&bar[XB_XCNT(j)]); sum += c; cnt += (c > 0u) ? 1u : 0u; mine = (j == x) ? c : mine; }
        if (sum == G) break;
        __builtin_amdgcn_s_sleep(1);
        if ((++sp & 255u) == 0u) { if (xb_ld(&bar[XB_TMO])) break; if (sp > XB_SPIN_CAP) { atomicAdd(&bar[XB_TMO], 1u); break; } }
    }
    nloc = mine > 0u ? mine : 1u; nx = cnt > 0u ? cnt : 1u;
}

__device__ __forceinline__ void xcd_barrier(const XcdBarrier& b) {
    asm volatile("s_waitcnt vmcnt(0)" ::: "memory");
    __syncthreads();
    if (threadIdx.x == 0) {
        unsigned* bar = b.bar;
        __builtin_amdgcn_s_waitcnt(0);
        unsigned nloc = b.st[0], nx = b.st[1];
        if (nloc == 0u) { xcd_barrier_complete(bar, b.x, nloc, nx); b.st[0] = nloc; b.st[1] = nx; }
        const unsigned old = xb_add(&bar[XB_XSUB(b.x)], 1u);
        const unsigned gen = old / nloc;
        if (old + 1u == (gen + 1u) * nloc) {
            __builtin_amdgcn_fence(__ATOMIC_RELEASE, "agent");
            asm volatile("s_waitcnt vmcnt(0)" ::: "memory");
            const unsigned og = xb_add(&bar[XB_TOP], 1u);
            const unsigned tg = og / nx;
            if (og + 1u == (tg + 1u) * nx) xb_add(&bar[XB_TOPGEN], 1u);
            else XB_SPIN(xb_ld(&bar[XB_TOPGEN]) == tg, bar);
            __builtin_amdgcn_fence(__ATOMIC_ACQUIRE, "agent");
            xb_add(&bar[XB_XGEN(b.x)], 1u);
            asm volatile("s_waitcnt vmcnt(0)" ::: "memory");
        } else {
            XB_SPIN(xb_ld(&bar[XB_XGEN(b.x)]) == gen, bar);
            __builtin_amdgcn_fence(__ATOMIC_ACQUIRE, "agent");
            asm volatile("s_waitcnt vmcnt(0)" ::: "memory");
        }
    }
    __syncthreads();
}

__global__ void __launch_bounds__(NTHR, 2) fwd_megakernel(Params P) {
    extern __shared__ __attribute__((aligned(16))) unsigned char lds_raw[];
    LAS unsigned char* lds0 = (LAS unsigned char*)lds_raw;
    cg::grid_group grid = cg::this_grid();
    { volatile LAS unsigned* stw = (volatile LAS unsigned*)(lds0 + 131072 + 256); if (threadIdx.x < 4) stw[threadIdx.x] = 0u; }
    __syncthreads();
    (void)xcd_barrier_post((unsigned*)(P.ws + WS_BAR), (volatile LAS unsigned*)(lds0 + 131072 + 256));
    const int nph = P.nph;
    {
        KP Q0 = (KP)__builtin_amdgcn_kernarg_segment_ptr(); asm volatile("" : "+s"(Q0));
        int tid0 = threadIdx.x; asm volatile("" : "+v"(tid0));
        prologue(Q0, lds0, (int)blockIdx.x, (int)gridDim.x, tid0, __builtin_amdgcn_readfirstlane(tid0 >> 6), tid0 & 63);
        XcdBarrier xb; xb.bar = (unsigned*)(Q0->ws + WS_BAR); xb.x = xb_xcc_id(); xb.st = (volatile LAS unsigned*)(lds0 + 131072 + 256); xcd_barrier(xb);
    }
    for (int ph = 1; ph < nph; ++ph) {
        KP Q = (KP)__builtin_amdgcn_kernarg_segment_ptr(); asm volatile("" : "+s"(Q));
        unsigned char* ws = Q->ws; asm volatile("" : "+s"(ws));
        int bid = blockIdx.x, G = gridDim.x; asm volatile("" : "+s"(bid), "+s"(G));
        LAS unsigned char* lds = lds0; asm volatile("" : "+s"(lds));
#define TLW int tid = threadIdx.x; asm volatile("" : "+v"(tid)); const int lane = tid & 63, w = __builtin_amdgcn_readfirstlane(tid >> 6); (void)lane; (void)w;
#define gw (bid * NWAVES + w)
#define ngw (G * NWAVES)
#define gt (bid * NTHR + tid)
#define ngt (G * NTHR)
#define mods ((float*)(ws + WS_MODS))
#define XN ((bf16*)(ws + WS_XN))
#define XR ((bf16*)Q->out)
#define XF ((bf16*)(ws + WS_BIG + 100 * MiB))
#define scr ((LAS float*)(lds + w * 8704))
#define modl (mods + (size_t)l * 2 * 9216)
        const int kind = Q->ph[ph][0], l = Q->ph[ph][1], sub = Q->ph[ph][2], b = Q->ph[ph][3];
        switch (kind) {
        case K_ROW: { TLW
            if (sub != 1) {
                const int fi = l * 2 + (sub >> 1);
                conv_job(Q->ffn_w_in + (size_t)fi * 1024 * 5632, 1024, 5632, (bf16*)(ws + WS_WB), 1, 2816, scr, gw, ngw, lane);
            } else if (l == 0) {
                conv_job(Q->ret_w_in, 1024, 6144, (bf16*)(ws + WS_WB), 2, 0, scr, gw, ngw, lane);
                conv_job(Q->ret_w_out, 2048, 1024, (bf16*)(ws + WS_WB2), 0, 0, scr, gw, ngw, lane);
            } else {
                conv_job(Q->w_glu, 1024, 2048, (bf16*)(ws + WS_WB), 1, 1024, scr, gw, ngw, lane);
                s5_build(Q, gt, ngt);
            }
            const void* xin = (l == 0 && sub == 0) ? (const void*)Q->x : (const void*)XR; const int in_f32 = (l == 0 && sub == 0) ? 1 : 0;
            row_pass(xin, in_f32, Q->norm_g + (size_t)(l * 3 + sub) * 1024, modl + 3072 * sub, modl + 3072 * sub + 1024, XN, (l == 1 && sub == 1) ? (bf16*)(ws + WS_XH) : (bf16*)nullptr, (l == 0 && sub == 0) ? XR : (bf16*)nullptr, gw, ngw, lane);
        } break;
        case K_FFN_IN: {
            pg8::Gemm g{XN, (const bf16*)(ws + WS_WB), Mtok, 2 * FF, Dm}; pg8::StaticOrder S; S.init(Mtok, 2 * FF, G, bid);
            pg8::EpiSwiGLU E{(bf16*)(ws + WS_H), FF};
            pg8::gemm_phase<pg8::EpiSwiGLU, pg8::StaticOrder, true, true>(lds, g, S, E);
            { TLW
              const int fi = l * 2 + (sub >> 1);
              if (G == 256) { if (bid >= 128) conv_job(Q->ffn_w_out + (size_t)fi * 2816 * 1024, 2816, 1024, (bf16*)(ws + WS_WB2), 0, 0, scr, (bid - 128) * NWAVES + w, 128 * NWAVES, lane); }
              else conv_job(Q->ffn_w_out + (size_t)fi * 2816 * 1024, 2816, 1024, (bf16*)(ws + WS_WB2), 0, 0, scr, gw, ngw, lane); }
        } break;
        case K_FFN_OUT: case K_RETOUT: {
            const bool isf = kind == K_FFN_OUT;
            pg8::Gemm g{isf ? (const bf16*)(ws + WS_H) : (const bf16*)(ws + WS_G), (const bf16*)(ws + WS_WB2), Mtok, Dm, isf ? FF : 2048}; pg8::StaticOrder S; S.init(Mtok, Dm, G, bid);
            pg8::EpiResid E{XR, (isf && l == 1 && sub == 2) ? XF : XR, modl + 3072 * sub + 2048, isf ? 0.5f : 1.0f};
            pg8::gemm_phase<pg8::EpiResid, pg8::StaticOrder, true, true>(lds, g, S, E);
        } break;
        case K_G3: {
            const float* rot = (const float*)(ws + WS_ROT) + (size_t)b * Lseq * 256;
            { pg8::Gemm g{XN + (size_t)b * Lseq * Dm, (const bf16*)(ws + WS_WB), Lseq, 4096, Dm}; pg8::StaticOrder S; S.init(Lseq, 4096, G, bid);
              pg8::EpiRet3a E{(bf16*)(ws + WS_G) + (size_t)b * Lseq * 2048, (bf16*)(ws + WS_Q), (bf16*)(ws + WS_K), (bf16*)(ws + WS_KT), rot};
              pg8::gemm_phase<pg8::EpiRet3a, pg8::StaticOrder, true, true>(lds, g, S, E); }
            { pg8::Gemm g{(const bf16*)(ws + WS_WB) + (size_t)4096 * Dm, XN + (size_t)b * Lseq * Dm, 2048, Lseq, Dm}; pg8::StaticOrder S; S.init(2048, Lseq, G, bid);
              pg8::EpiRet3b E{(bf16*)(ws + WS_VT)};
              pg8::gemm_phase<pg8::EpiRet3b, pg8::StaticOrder, true, true>(lds, g, S, E); }
        } break;
        case K_R1: { TLW r1_phase((const bf16*)(ws + WS_KT), (const bf16*)(ws + WS_VT), (bf16*)(ws + WS_KV), lds, bid, G, w, lane); } break;
        case K_R2: { TLW r2_phase((bf16*)(ws + WS_KV), gt, ngt); } break;
        case K_R3: { TLW r3_phase((const bf16*)(ws + WS_Q), (const bf16*)(ws + WS_KT), (const bf16*)(ws + WS_VT), (const bf16*)(ws + WS_KV), (bf16*)(ws + WS_G) + (size_t)b * Lseq * 2048, lds, bid, G, tid, w, lane); } break;
        case K_S5A: {
            pg8::Gemm g{(const bf16*)(ws + WS_XH), (const bf16*)(ws + WS_SP), 65536, 256, 384}; pg8::S5Order S{G, bid};
            pg8::EpiS5A E{(float*)(ws + WS_SLOC)};
            pg8::gemm_phase<pg8::EpiS5A, pg8::S5Order, true, true>(lds, g, S, E);
        } break;
        case K_S5B: { TLW s5b_phase((const float*)(ws + WS_SLOC), (const f32x2*)(ws + WS_APW), (bf16*)(ws + WS_XH), lds, bid, G, w, lane); } break;
        case K_S5C: {
            pg8::Gemm g{(const bf16*)(ws + WS_XH), (const bf16*)(ws + WS_TC), 65536, 256, 384}; pg8::S5Order S{G, bid};
            pg8::EpiS5C E{XN, Q->s5_d, (bf16*)(ws + WS_YG)};
            pg8::gemm_phase<pg8::EpiS5C, pg8::S5Order, true, true>(lds, g, S, E);
        } break;
        case K_GLU: {
            pg8::Gemm g{(const bf16*)(ws + WS_YG), (const bf16*)(ws + WS_WB), Mtok, 2048, Dm}; pg8::StaticOrder S; S.init(Mtok, 2048, G, bid);
            pg8::EpiGLU E{XR, modl + 3072 + 2048};
            pg8::gemm_phase<pg8::EpiGLU, pg8::StaticOrder, true, true>(lds, g, S, E);
        } break;
        case K_FINAL: { TLW final_norm(XF, Q->out, Q->final_g, gw, ngw, lane); } break;
        default: break;
        }
        if (ph + 1 < nph) { if (nph > MAXPH) grid.sync();   else { XcdBarrier xb; xb.bar = (unsigned*)(ws + WS_BAR); xb.x = xb_xcc_id(); xb.st = (volatile LAS unsigned*)(lds + 131072 + 256); xcd_barrier(xb); } }
    }
}

#undef TLW
#undef gw
#undef ngw
#undef gt
#undef ngt
#undef mods
#undef XN
#undef XR
#undef XF
#undef scr
#undef modl
extern "C" void kernel_launch(void* const* d_in, const int* in_sizes, int n_in, void* d_out, int out_size, void* d_ws, size_t ws_size, hipStream_t stream) {
    static int grid = 0;
    if (grid == 0) {
        if (n_in != 20 || in_sizes[0] != Mtok * Dm || out_size != Mtok * Dm || ws_size < WS_END) {
            fprintf(stderr, "kernel_launch: unexpected problem (n_in %d, in0 %d, out %d, ws %zu, need %zu); nothing launched\n", n_in, n_in > 0 ? in_sizes[0] : -1, out_size, ws_size, (size_t)WS_END);
            grid = -1; return;
        }
        int dev = 0, cus = 0, per_cu = 0;
        hipGetDevice(&dev);
        hipDeviceGetAttribute(&cus, hipDeviceAttributeMultiprocessorCount, dev);
        hipFuncSetAttribute((const void*)fwd_megakernel, hipFuncAttributeMaxDynamicSharedMemorySize, LDS_BYTES);
        hipOccupancyMaxActiveBlocksPerMultiprocessor(&per_cu, (const void*)fwd_megakernel, NTHR, LDS_BYTES);
        if (per_cu < 1) { fprintf(stderr, "kernel_launch: occupancy query reports %d blocks per CU; nothing launched\n", per_cu); grid = -1; return; }
        grid = cus;
        fprintf(stderr, "kernel_launch: grid %d (per_cu %d), ws %zu\n", grid, per_cu, ws_size);
    }
    if (grid < 0) return;
    Params p{};
    p.x = (const float*)d_in[0]; p.c = (const float*)d_in[1]; p.pos = (const int*)d_in[2]; p.ada_w = (const float*)d_in[3]; p.ada_b = (const float*)d_in[4];
    p.norm_g = (const float*)d_in[5]; p.ffn_w_in = (const float*)d_in[6]; p.ffn_w_out = (const float*)d_in[7]; p.ret_w_in = (const float*)d_in[8]; p.ret_w_out = (const float*)d_in[9];
    p.a_re = (const float*)d_in[10]; p.a_im = (const float*)d_in[11]; p.b_re = (const float*)d_in[12]; p.b_im = (const float*)d_in[13]; p.c_re = (const float*)d_in[14]; p.c_im = (const float*)d_in[15];
    p.s5_d = (const float*)d_in[16]; p.log_dt = (const float*)d_in[17]; p.w_glu = (const float*)d_in[18]; p.final_g = (const float*)d_in[19];
    p.out = (float*)d_out; p.ws = (unsigned char*)d_ws;
    int n = 0;
    auto add = [&](int k, int l, int s, int b) { p.ph[n][0] = (unsigned char)k; p.ph[n][1] = (unsigned char)l; p.ph[n][2] = (unsigned char)s; p.ph[n][3] = (unsigned char)b; ++n; };
#ifndef EXP
#define EXP 0
#endif
    const int rPRO = (EXP == 1) ? 2 : 1, rROW = (EXP == 1) ? 2 : 1, rRET = (EXP == 2) ? 2 : 1, rS5 = (EXP == 3) ? 2 : 1, rFIN = (EXP == 4) ? 2 : 1;
    for (int r = 0; r < rPRO; ++r) add(K_PRO, 0, 0, 0);
    for (int l = 0; l < 2; ++l)
        for (int s = 0; s < 3; ++s) {
            for (int r = 0; r < rROW; ++r) add(K_ROW, l, s, 0);
            if (s != 1) { for (int r = 0; r < rFIN; ++r) add(K_FFN_IN, l, s, 0); add(K_FFN_OUT, l, s, 0); }
            else if (l == 0) { for (int b = 0; b < 2; ++b) for (int r = 0; r < rRET; ++r) { add(K_G3, 0, 1, b); add(K_R1, 0, 1, b); add(K_R2, 0, 1, b); add(K_R3, 0, 1, b); } add(K_RETOUT, 0, 1, 0); }
            else { for (int r = 0; r < rS5; ++r) add(K_S5A, 1, 1, 0); for (int r = 0; r < rS5; ++r) add(K_S5B, 1, 1, 0); for (int r = 0; r < rS5; ++r) add(K_S5C, 1, 1, 0); add(K_GLU, 1, 1, 0); }
        }
    add(K_FINAL, 0, 0, 0);
    p.nph = n;
    hipMemsetAsync((char*)d_ws + WS_BAR, 0, 16384, stream);
    void* args[] = {&p};
    hipError_t e = hipLaunchCooperativeKernel((const void*)fwd_megakernel, dim3(grid), dim3(NTHR), args, LDS_BYTES, stream);
    if (e != hipSuccess) fprintf(stderr, "kernel_launch: cooperative launch failed: %s (grid %d)\n", hipGetErrorString(e), grid);
}
```
